# Optimizing an MI355X kernel written in HIP

```python
import math
import jax, jax.numpy as jnp
from jax import lax
import numpy as np

D_MODEL = 1024
BATCH = 16
SEQ = 2048
DEPTH = 2

MEM_LEN = 256
D_MIX = D_MODEL
GM_WIDTH = D_MIX // 2
CHUNK = 128
GM_HEAD_DIM = 128
GM_HEADS = GM_WIDTH // GM_HEAD_DIM
SSM_WIDTH = D_MIX // 4
SSM_GROUP = 16
SSM_GROUPS = SSM_WIDTH // SSM_GROUP
SSM_STATE = 64
XA_WIDTH = D_MIX - GM_WIDTH - SSM_WIDTH
XA_HEADS = 4
XA_HEAD_DIM = XA_WIDTH // XA_HEADS
IN_WIDTH = 3 * GM_WIDTH + 2 * SSM_WIDTH + 2 * XA_WIDTH
SPLITS = (GM_WIDTH, 2 * GM_WIDTH, 3 * GM_WIDTH,
          3 * GM_WIDTH + SSM_WIDTH, 3 * GM_WIDTH + 2 * SSM_WIDTH,
          3 * GM_WIDTH + 2 * SSM_WIDTH + XA_WIDTH)
DN_ALPHA = (2 * DEPTH) ** 0.25
DN_BETA = (8 * DEPTH) ** -0.25
LN_EPS = 1e-5
DT_MIN = 0.001
DT_MAX = 0.1

kernel_name = "hybrid_gmlp_s5_memxattn_deepnorm"


def layer_norm(x, g, b):
    xf = x.astype(jnp.float32)
    mu = jnp.mean(xf, axis=-1, keepdims=True)
    xc = xf - mu
    var = jnp.mean(xc * xc, axis=-1, keepdims=True)
    return (xc * lax.rsqrt(var + LN_EPS) * g.astype(jnp.float32) + b.astype(jnp.float32)).astype(x.dtype)


def spatial_gating(u, v, w_s, b_s, ln_g, ln_b, causal):
    Bsz, L, _ = v.shape
    nc = L // CHUNK
    vh = layer_norm(v.reshape(Bsz, L, GM_HEADS, GM_HEAD_DIM), ln_g, ln_b)
    w = jnp.where(causal[None], w_s, 0)
    vc = vh.reshape(Bsz, nc, CHUNK, GM_HEADS, GM_HEAD_DIM)
    mixed = jnp.einsum('hts,bcshd->bcthd', w, vc) + b_s.T[None, None, :, :, None]
    return u * mixed.reshape(Bsz, L, GM_WIDTH)


def _diag_combine(c1, c2):
    a1, b1 = c1
    a2, b2 = c2
    return a1 * a2, a2 * b1 + b2


def s5_branch(xs, lam_re, lam_im, log_step, b_re, b_im, c_re, c_im, d_skip, glu_w, glu_b):
    f32 = jnp.float32
    Bsz, L, W = xs.shape
    xg = xs.reshape(Bsz, L, SSM_GROUPS, SSM_GROUP).astype(f32)
    lam = lax.complex(lam_re.astype(f32), lam_im.astype(f32))
    step = jnp.exp(log_step.astype(f32))[:, None]
    lam_bar = jnp.exp(lam * step)
    b_mat = lax.complex(b_re.astype(f32), b_im.astype(f32))
    b_bar = ((lam_bar - 1.0) / lam)[:, :, None] * b_mat
    c_mat = lax.complex(c_re.astype(f32), c_im.astype(f32))
    bu = jnp.einsum('gpc,blgc->blgp', b_bar, xg.astype(jnp.complex64))
    decay = jnp.broadcast_to(lam_bar, bu.shape)
    _, h = lax.associative_scan(_diag_combine, (decay, bu), axis=1)
    y = jnp.einsum('gcp,blgp->blgc', c_mat, h).real \
        + d_skip.astype(f32).reshape(SSM_GROUPS, SSM_GROUP) * xg
    y = jax.nn.gelu(y.reshape(Bsz, L, W)).astype(xs.dtype)
    return y * jax.nn.sigmoid(y @ glu_w + glu_b)


def memory_cross_attention(q, mem, w_k, w_v):
    Bsz, L, _ = q.shape
    M = mem.shape[1]
    qh = q.reshape(Bsz, L, XA_HEADS, XA_HEAD_DIM)
    kh = (mem @ w_k).reshape(Bsz, M, XA_HEADS, XA_HEAD_DIM)
    vh = (mem @ w_v).reshape(Bsz, M, XA_HEADS, XA_HEAD_DIM)
    s = jnp.einsum('blhd,bmhd->bhlm', qh, kh, preferred_element_type=jnp.float32)
    p = jax.nn.softmax(s * (XA_HEAD_DIM ** -0.5), axis=-1).astype(vh.dtype)
    o = jnp.einsum('bhlm,bmhd->blhd', p, vh)
    return o.reshape(Bsz, L, XA_WIDTH)


def setup_inputs(seed: int = 0) -> dict:
    key = jax.random.key(seed)
    ks = jax.random.split(key, 24)
    f32 = jnp.float32
    nrm = lambda k, shape, s: jax.random.normal(k, shape, f32) * s
    x = jax.random.normal(ks[0], (BATCH, SEQ, D_MODEL), f32)
    mem = jax.random.normal(ks[1], (BATCH, MEM_LEN, D_MODEL), f32)
    w_in = nrm(ks[2], (DEPTH, D_MODEL, IN_WIDTH), D_MODEL ** -0.5)
    gm_w_s = nrm(ks[3], (DEPTH, GM_HEADS, CHUNK, CHUNK), CHUNK ** -0.5)
    gm_b_s = 1.0 + nrm(ks[4], (DEPTH, GM_HEADS, CHUNK), 0.01)
    gm_ln_g = 1.0 + nrm(ks[5], (DEPTH, GM_HEADS, GM_HEAD_DIM), 0.01)
    gm_ln_b = nrm(ks[6], (DEPTH, GM_HEADS, GM_HEAD_DIM), 0.01)
    n = jnp.arange(SSM_STATE, dtype=f32)
    ssm_lam_re = -0.5 + nrm(ks[7], (DEPTH, SSM_GROUPS, SSM_STATE), 0.01)
    ssm_lam_im = math.pi * n + nrm(ks[8], (DEPTH, SSM_GROUPS, SSM_STATE), 0.01)
    ssm_log_step = jax.random.uniform(ks[9], (DEPTH, SSM_GROUPS), f32,
                                      math.log(DT_MIN), math.log(DT_MAX))
    bs = (2.0 * SSM_GROUP) ** -0.5
    ssm_b_re = nrm(ks[10], (DEPTH, SSM_GROUPS, SSM_STATE, SSM_GROUP), bs)
    ssm_b_im = nrm(ks[11], (DEPTH, SSM_GROUPS, SSM_STATE, SSM_GROUP), bs)
    cs = (2.0 * SSM_STATE) ** -0.5
    ssm_c_re = nrm(ks[12], (DEPTH, SSM_GROUPS, SSM_GROUP, SSM_STATE), cs)
    ssm_c_im = nrm(ks[13], (DEPTH, SSM_GROUPS, SSM_GROUP, SSM_STATE), cs)
    ssm_d = nrm(ks[14], (DEPTH, SSM_WIDTH), 1.0)
    glu_w = nrm(ks[15], (DEPTH, SSM_WIDTH, SSM_WIDTH), SSM_WIDTH ** -0.5)
    glu_b = nrm(ks[16], (DEPTH, SSM_WIDTH), 0.01)
    xa_w_k = nrm(ks[17], (DEPTH, D_MODEL, XA_WIDTH), D_MODEL ** -0.5)
    xa_w_v = nrm(ks[18], (DEPTH, D_MODEL, XA_WIDTH), D_MODEL ** -0.5)
    w_out = nrm(ks[19], (DEPTH, D_MIX, D_MODEL), DN_BETA * D_MIX ** -0.5)
    ln_g = 1.0 + nrm(ks[20], (DEPTH, D_MODEL), 0.01)
    ln_b = nrm(ks[21], (DEPTH, D_MODEL), 0.01)
    return {"x": x, "mem": mem, "w_in": w_in, "gm_w_s": gm_w_s, "gm_b_s": gm_b_s,
            "gm_ln_g": gm_ln_g, "gm_ln_b": gm_ln_b, "ssm_lam_re": ssm_lam_re,
            "ssm_lam_im": ssm_lam_im, "ssm_log_step": ssm_log_step,
            "ssm_b_re": ssm_b_re, "ssm_b_im": ssm_b_im, "ssm_c_re": ssm_c_re,
            "ssm_c_im": ssm_c_im, "ssm_d": ssm_d, "glu_w": glu_w, "glu_b": glu_b,
            "xa_w_k": xa_w_k, "xa_w_v": xa_w_v, "w_out": w_out,
            "ln_g": ln_g, "ln_b": ln_b}


def reference(x, mem, w_in, gm_w_s, gm_b_s, gm_ln_g, gm_ln_b, ssm_lam_re, ssm_lam_im,
              ssm_log_step, ssm_b_re, ssm_b_im, ssm_c_re, ssm_c_im, ssm_d, glu_w, glu_b,
              xa_w_k, xa_w_v, w_out, ln_g, ln_b):
    causal = jnp.tril(jnp.ones((CHUNK, CHUNK), dtype=bool))
    for layer in range(DEPTH):
        z = x @ w_in[layer]
        u_a, v_a, g_a, x_b, g_b, q_x, g_x = jnp.split(z, SPLITS, axis=-1)
        y_a = spatial_gating(jax.nn.gelu(u_a), jax.nn.gelu(v_a), gm_w_s[layer], gm_b_s[layer],
                             gm_ln_g[layer], gm_ln_b[layer], causal)
        y_b = s5_branch(x_b, ssm_lam_re[layer], ssm_lam_im[layer], ssm_log_step[layer],
                        ssm_b_re[layer], ssm_b_im[layer], ssm_c_re[layer], ssm_c_im[layer],
                        ssm_d[layer], glu_w[layer], glu_b[layer])
        y_x = memory_cross_attention(q_x, mem, xa_w_k[layer], xa_w_v[layer])
        y = jnp.concatenate([y_a * jax.nn.silu(g_a),
                             y_b * jax.nn.silu(g_b),
                             y_x * jax.nn.silu(g_x)], axis=-1)
        x = layer_norm(DN_ALPHA * x + y @ w_out[layer], ln_g[layer], ln_b[layer])
    return x
```

```cpp
#include <hip/hip_runtime.h>
#include <hip/hip_cooperative_groups.h>
#include <cstdio>
#include <cstdint>
namespace cg = cooperative_groups;

typedef unsigned short bf16_t;
typedef short bf16x8 __attribute__((ext_vector_type(8)));
typedef float f32x4 __attribute__((ext_vector_type(4)));
typedef float f32x2 __attribute__((ext_vector_type(2)));
typedef unsigned u32x4 __attribute__((ext_vector_type(4)));
typedef unsigned u32x2 __attribute__((ext_vector_type(2)));
#define DI __device__ __forceinline__

constexpr int T_TOK = 32768, DM = 1024;
constexpr int NTHR = 512;
constexpr size_t OFF_XB0 = 0;
constexpr size_t OFF_XB1 = OFF_XB0 + (size_t)T_TOK * DM * 2;
constexpr size_t OFF_X1 = OFF_XB1 + (size_t)T_TOK * DM * 2;
constexpr size_t OFF_Y = OFF_X1 + (size_t)T_TOK * DM * 4;
constexpr size_t OFF_PRE = OFF_Y + (size_t)T_TOK * DM * 2;
constexpr size_t OFF_XBB = OFF_PRE;
constexpr size_t OFF_YS = OFF_PRE + (size_t)T_TOK * 256 * 2;
constexpr size_t OFF_SG = OFF_PRE + (size_t)T_TOK * 256 * 4;
constexpr size_t OFF_HL = OFF_SG + (size_t)T_TOK * 256 * 2;
constexpr size_t OFF_MEMB = OFF_HL + (size_t)256 * 1024 * 2 * 4;
constexpr size_t OFF_WIN = OFF_MEMB + (size_t)4096 * 1024 * 2;
constexpr size_t OFF_WOUT = OFF_WIN + (size_t)2 * 2560 * 1024 * 2;
constexpr size_t OFF_WGLU = OFF_WOUT + (size_t)2 * 1024 * 1024 * 2;
constexpr size_t OFF_WKV = OFF_WGLU + (size_t)2 * 256 * 256 * 2;
constexpr size_t OFF_WSP = OFF_WKV + (size_t)2 * 512 * 1024 * 2;
constexpr size_t OFF_S5T = OFF_WSP + (size_t)2 * 4 * 128 * 128 * 2;
constexpr size_t OFF_L8 = OFF_S5T + (size_t)32 * 3 * 128 * 128 * 2;
constexpr size_t OFF_L128 = OFF_L8 + (size_t)32 * 64 * 2 * 4;
constexpr size_t OFF_KB = OFF_L128 + (size_t)32 * 64 * 2 * 4;
constexpr size_t OFF_VP = OFF_KB + (size_t)2 * 4096 * 256 * 2;
constexpr size_t OFF_GX = OFF_VP + (size_t)2 * 4096 * 256 * 2;
constexpr size_t WS_TOTAL = OFF_GX + (size_t)T_TOK * 256 * 2;

constexpr int LDS_BYTES = 147456;
constexpr float LN_EPS = 1e-5f;
constexpr float DN_ALPHA = 1.41421356237f;

struct Params {
    const float *x, *mem, *w_in, *gm_w_s, *gm_b_s, *gm_ln_g, *gm_ln_b, *lam_re, *lam_im, *log_step, *b_re, *b_im, *c_re, *c_im, *ssm_d, *glu_w, *glu_b, *w_k,
        *w_v, *w_out, *ln_g, *ln_b;
    float* out;
    char* ws;
};

typedef __bf16 bf16x2_t __attribute__((ext_vector_type(2)));
DI unsigned pk2(float lo, float hi) { const f32x2 v = {lo, hi}; const bf16x2_t b = __builtin_convertvector(v, bf16x2_t); return __builtin_bit_cast(unsigned, b); }
DI unsigned bf16_bits(float x) { return pk2(x, 0.f) & 0xffffu; }
DI float bf2f(unsigned b) { return __uint_as_float(b << 16); }
DI float sigmoid_f(float x) { return __builtin_amdgcn_rcpf(1.f + __builtin_amdgcn_exp2f(x * -1.44269504089f)); }
DI float silu_f(float x) { return x * sigmoid_f(x); }
DI float gelu_f(float x) {
    const float t = x * (-2.30220819f + -0.102943240f * (x * x));
    return x * __builtin_amdgcn_rcpf(1.f + __builtin_amdgcn_exp2f(t));
}
DI int opaque_tid() { int t = threadIdx.x; asm volatile("" : "+v"(t)); return t; }
DI f32x4 mfma16(bf16x8 a, bf16x8 b, f32x4 c) { return __builtin_amdgcn_mfma_f32_16x16x32_bf16(a, b, c, 0, 0, 0); }

template <int N> DI void wait_vm() { asm volatile("s_waitcnt vmcnt(%0)" ::"n"(N) : "memory"); }
DI void raw_barrier() { asm volatile("" ::: "memory"); __builtin_amdgcn_s_barrier(); asm volatile("" ::: "memory"); }

template <int BM, int BN, int WR, int WC, int NSEG, bool SWAP, int NST, int DBG = 0>
DI void gemm_main(const bf16_t* __restrict__ A, const bf16_t* __restrict__ Bt, const int ldbk, char* lds, f32x4 (&acc)[BM / WR / 16][BN / WC / 16]) {
    constexpr int WM = BM / WR, WN = BN / WC, MT = WM / 16, NT = WN / 16, ROWS = BM + BN, NCH = ROWS * 4, NIT = (NCH + 511) / 512, BUF = ROWS * 64, KT = 32;
    constexpr int NTS = NT / NSEG, D = NST - 1;
    static_assert(D == 1 || (NCH % 512 == 0), "deep ring needs a uniform per-thread load count");
    const int tid = opaque_tid(), lane = tid & 63, wid = tid >> 6, wr = wid / WC, wc = wid % WC, l15 = lane & 15, quad = lane >> 4;
    const int lrow = tid >> 2, lc = tid & 3;
    const int lcg = lc ^ ((0 - (tid >> 4)) & 3);
    const int rsw = (quad ^ ((0 - (l15 >> 2)) & 3)) << 4;
#pragma unroll
    for (int mt = 0; mt < MT; ++mt)
#pragma unroll
        for (int nt = 0; nt < NT; ++nt) acc[mt][nt] = (f32x4){0.f, 0.f, 0.f, 0.f};
    const unsigned loff = (unsigned)(lrow * 64 + lcg * 16);
    const int koff = (int)((blockIdx.x >> 3) + (blockIdx.x & 7) * 4) & (KT - 1);
    auto issue_one = [&](int kt, int b, int i) {
        const int row = lrow + 128 * i;
        if ((NCH % 512 == 0) || (i < NCH / 512) || row < ROWS) {
            const int kq = (kt + koff) & (KT - 1);
            const char* ua = (const char*)A + (size_t)((DBG & 1) ? 0 : kq) * (BM * 64);
            const char* ub = (const char*)Bt + (size_t)((DBG & 2) ? 0 : kq) * ((size_t)ldbk * 2);
            const char* src;
            if (BM % 128 == 0) src = (i < BM / 128) ? (ua + i * 8192 + loff) : (ub + (i * 128 - BM) * 64 + loff);
            else if (i == 0) src = (lrow < BM) ? (ua + loff) : (ub + loff - BM * 64);
            else src = ub + (i * 128 - BM) * 64 + loff;
            __builtin_amdgcn_global_load_lds((const unsigned*)src, (unsigned*)(lds + b * BUF + i * 8192 + tid * 16), 16, 0, 0);
        }
    };
    auto issue = [&](int kt, int b) {
#pragma unroll
        for (int i = 0; i < NIT; ++i) issue_one(kt, b, i);
    };
    auto compute = [&](int cb, bool do_issue, int ikt, int ib) {
        const char* base = lds + cb * BUF;
        bf16x8 af[MT], bfr[NT];
#pragma unroll
        for (int nt = 0; nt < NT; ++nt) {
            const int br = BM + (nt / NTS) * (BN / NSEG) + wc * (NTS * 16) + (nt % NTS) * 16;
            bfr[nt] = *(const bf16x8*)(base + (br + l15) * 64 + rsw);
        }
#pragma unroll
        for (int mt = 0; mt < MT; ++mt) af[mt] = *(const bf16x8*)(base + (wr * WM + mt * 16 + l15) * 64 + rsw);
        constexpr int TOT = MT * NT, PER = (TOT + NIT - 1) / NIT;
#pragma unroll
        for (int part = 0; part < NIT; ++part) {
#pragma unroll
            for (int q = 0; q < PER; ++q) {
                const int idx = part * PER + q;
                if (idx < TOT) {
                    const int mt = idx / NT, nt = idx % NT;
                    acc[mt][nt] = SWAP ? mfma16(bfr[nt], af[mt], acc[mt][nt]) : mfma16(af[mt], bfr[nt], acc[mt][nt]);
                }
            }
            __builtin_amdgcn_sched_barrier(0);
            if (do_issue) issue_one(ikt, ib, part);
            __builtin_amdgcn_sched_barrier(0);
        }
    };
    __syncthreads();
#pragma unroll
    for (int d = 0; d < D; ++d) issue(d, d);
    int cb = 0, ib = D;
    for (int kt = 0; kt < KT; ++kt) {
        if (D > 1 && kt + D - 1 < KT) wait_vm<(D - 1) * NIT>(); else wait_vm<0>();
        raw_barrier();
        compute(cb, kt + D < KT, kt + D, ib);
        cb = (cb + 1 == NST) ? 0 : cb + 1;
        ib = (ib + 1 == NST) ? 0 : ib + 1;
    }
    __syncthreads();
}

DI size_t y_off(int tok, int col) { return ((size_t)(((tok >> 6) * 32 + (col >> 5)) * 64 + (tok & 63))) * 32 + (col & 31); }
DI size_t xb_off(int tok, int col) { return ((size_t)(((tok >> 7) * 32 + (col >> 5)) * 128 + (tok & 127))) * 32 + (col & 31); }
#define WS_PTR(T, off) ((T*)(p.ws + (off)))

DI void transpose_tile(const float* __restrict__ src, int ldsrc, bf16_t* __restrict__ dst, int ntot, int n0, int k0, float* tile) {
    const int tid = threadIdx.x, c = tid & 63, r0 = tid >> 6;
#pragma unroll
    for (int i = 0; i < 8; ++i) { const int r = r0 + 8 * i; tile[r * 65 + c] = src[(size_t)r * ldsrc + c]; }
    __syncthreads();
#pragma unroll
    for (int i = 0; i < 8; ++i) {
        const int rr = r0 + 8 * i, k = k0 + c;
        dst[((size_t)(k >> 5) * ntot + n0 + rr) * 32 + (k & 31)] = (bf16_t)bf16_bits(tile[c * 65 + rr]);
    }
    __syncthreads();
}

DI void transpose_glu(const float* __restrict__ src, bf16_t* __restrict__ dst, float* tile) {
    const int tid = threadIdx.x, c = tid & 63, r0 = tid >> 6;
#pragma unroll
    for (int i = 0; i < 8; ++i) { const int r = r0 + 8 * i; tile[r * 65 + c] = src[(size_t)r * 256 + c]; }
    __syncthreads();
#pragma unroll
    for (int i = 0; i < 8; ++i) { const int rr = r0 + 8 * i; dst[(size_t)rr * 256 + c] = (bf16_t)bf16_bits(tile[c * 65 + rr]); }
    __syncthreads();
}

DI void s5_tables(const Params& p, char* lds, int lg) {
    const int tid = threadIdx.x;
    float* Lr = (float*)lds;
    float* Li = Lr + 9 * 64;
    float* Wr = Li + 9 * 64;
    float* Wi = Wr + 64;
    float* Bbr = Wi + 64;
    float* Bbi = Bbr + 1024;
    float* Cr = Bbi + 1024;
    float* Ci = Cr + 1024;
    float* Kt = Ci + 1024;
    __syncthreads();
    if (tid < 64) {
        const int pp = tid;
        const float dt = __expf(p.log_step[lg]);
        const float lr = p.lam_re[lg * 64 + pp], li = p.lam_im[lg * 64 + pp];
        const float a = lr * dt, b = li * dt;
        const float ea = expf(a);
        float sb, cb;
        sincosf(b, &sb, &cb);
        const float Lre = ea * cb, Lim = ea * sb;
        const float sh = sinf(0.5f * b);
        const float m1r = expm1f(a) * cb - 2.f * sh * sh, m1i = ea * sb;
        const float inv = 1.f / (lr * lr + li * li);
        Wr[pp] = (m1r * lr + m1i * li) * inv;
        Wi[pp] = (m1i * lr - m1r * li) * inv;
        float pr = 1.f, pi = 0.f;
#pragma unroll
        for (int t = 0; t < 9; ++t) {
            Lr[t * 64 + pp] = pr; Li[t * 64 + pp] = pi;
            const float nr = pr * Lre - pi * Lim, ni = pr * Lim + pi * Lre;
            pr = nr; pi = ni;
        }
        float qr = Lr[8 * 64 + pp], qi = Li[8 * 64 + pp];
        f32x2* L8 = WS_PTR(f32x2, OFF_L8);
        L8[lg * 64 + pp] = (f32x2){qr, qi};
#pragma unroll
        for (int s = 0; s < 4; ++s) { const float nr = qr * qr - qi * qi, ni = 2.f * qr * qi; qr = nr; qi = ni; }
        f32x2* L128 = WS_PTR(f32x2, OFF_L128);
        L128[lg * 64 + pp] = (f32x2){qr, qi};
    }
    __syncthreads();
    for (int e = tid; e < 1024; e += NTHR) {
        const int pp = e >> 4;
        const float br = p.b_re[lg * 1024 + e], bi = p.b_im[lg * 1024 + e];
        Bbr[e] = Wr[pp] * br - Wi[pp] * bi;
        Bbi[e] = Wr[pp] * bi + Wi[pp] * br;
        Cr[e] = p.c_re[lg * 1024 + e];
        Ci[e] = p.c_im[lg * 1024 + e];
    }
    __syncthreads();
    for (int e = tid; e < 2048; e += NTHR) {
        const int tau = e >> 8, c = (e >> 4) & 15, c2 = e & 15;
        float s = 0.f;
        for (int pp = 0; pp < 64; ++pp) {
            const float cr = Cr[c * 64 + pp], ci = Ci[c * 64 + pp], lr = Lr[tau * 64 + pp], li = Li[tau * 64 + pp];
            const float tr = cr * lr - ci * li, ti = cr * li + ci * lr;
            s += tr * Bbr[pp * 16 + c2] - ti * Bbi[pp * 16 + c2];
        }
        Kt[e] = s;
    }
    __syncthreads();
    bf16_t* T = WS_PTR(bf16_t, OFF_S5T) + (size_t)lg * 3 * 16384;
    for (int e = tid; e < 16384; e += NTHR) {
        const int n = e >> 7, k = e & 127;
        {
            const int tlo = n >> 4, c = n & 15, tli = k >> 4, c2 = k & 15;
            const float v = (tli <= tlo) ? Kt[((tlo - tli) * 16 + c) * 16 + c2] : 0.f;
            T[e] = (bf16_t)bf16_bits(v);
        }
        {
            const int pp = n & 63, ri = n >> 6, tli = k >> 4, c2 = k & 15;
            const float lr = Lr[(7 - tli) * 64 + pp], li = Li[(7 - tli) * 64 + pp], br = Bbr[pp * 16 + c2], bi = Bbi[pp * 16 + c2];
            const float v = ri ? (lr * bi + li * br) : (lr * br - li * bi);
            T[16384 + e] = (bf16_t)bf16_bits(v);
        }
        {
            const int tlo = n >> 4, c = n & 15, pp = k & 63, ri = k >> 6;
            const float lr = Lr[(tlo + 1) * 64 + pp], li = Li[(tlo + 1) * 64 + pp], cr = Cr[c * 64 + pp], ci = Ci[c * 64 + pp];
            const float v = ri ? -(cr * li + ci * lr) : (cr * lr - ci * li);
            T[32768 + e] = (bf16_t)bf16_bits(v);
        }
    }
    __syncthreads();
}

DI void prep_phase(const Params& p, char* lds) {
    const int tid = opaque_tid(), nb = gridDim.x, bid = blockIdx.x;
    for (int j = bid; j < 32; j += nb) s5_tables(p, lds, j);
    {
        float* tile = (float*)lds;
        for (int T = bid; T < 2080; T += nb) {
            const int l = T / 1040; int r = T % 1040;
            if (r < 640) {
                const int nt = r >> 4, kt = r & 15, n0 = nt * 64;
                int sc = n0;
                if (n0 < 1536) { const int h = n0 / 384, rem = n0 % 384, seg = rem >> 7, d0 = rem & 127; sc = seg * 512 + h * 128 + d0; }
                transpose_tile(p.w_in + (size_t)l * 1024 * 2560 + (size_t)(kt * 64) * 2560 + sc, 2560, WS_PTR(bf16_t, OFF_WIN) + (size_t)l * 2560 * 1024, 2560, n0, kt * 64, tile);
            } else if (r < 896) {
                r -= 640; const int nt = r >> 4, kt = r & 15;
                transpose_tile(p.w_out + (size_t)l * 1024 * 1024 + (size_t)(kt * 64) * 1024 + nt * 64, 1024, WS_PTR(bf16_t, OFF_WOUT) + (size_t)l * 1024 * 1024, 1024, nt * 64, kt * 64, tile);
            } else if (r < 912) {
                r -= 896; const int nt = r >> 2, kt = r & 3;
                transpose_glu(p.glu_w + (size_t)l * 65536 + (size_t)(kt * 64) * 256 + nt * 64, WS_PTR(bf16_t, OFF_WGLU) + (size_t)l * 65536 + (size_t)(nt * 64) * 256 + kt * 64, tile);
            } else if (r < 976) {
                r -= 912; const int nt = r >> 4, kt = r & 15;
                transpose_tile(p.w_k + (size_t)l * 262144 + (size_t)(kt * 64) * 256 + nt * 64, 256, WS_PTR(bf16_t, OFF_WKV) + (size_t)l * 524288, 512, nt * 64, kt * 64, tile);
            } else {
                r -= 976; const int nt = r >> 4, kt = r & 15;
                transpose_tile(p.w_v + (size_t)l * 262144 + (size_t)(kt * 64) * 256 + nt * 64, 256, WS_PTR(bf16_t, OFF_WKV) + (size_t)l * 524288, 512, 256 + nt * 64, kt * 64, tile);
            }
        }
    }
    {
        bf16_t* W = WS_PTR(bf16_t, OFF_WSP);
        for (int e = bid * NTHR + tid; e < 2 * 4 * 128 * 128; e += nb * NTHR) {
            const int s = e & 127, t = (e >> 7) & 127;
            W[e] = (s <= t) ? (bf16_t)bf16_bits(p.gm_w_s[e]) : (bf16_t)0;
        }
    }
    {
        auto conv = [&](const float* __restrict__ srcp, bf16_t* __restrict__ dstp, size_t n8) {
            for (size_t I = (size_t)bid * NTHR + tid; I < n8; I += (size_t)nb * NTHR) {
                const int c8 = (int)(I & 3), row = (int)(I >> 2) & 127, kt = (int)(I >> 9) & 31, blk = (int)(I >> 14);
                const float* s = srcp + ((size_t)(blk * 128 + row)) * 1024 + kt * 32 + c8 * 8;
                const f32x4 a = *(const f32x4*)s, b = *(const f32x4*)(s + 4);
                *(u32x4*)(dstp + I * 8) = (u32x4){pk2(a[0], a[1]), pk2(a[2], a[3]), pk2(b[0], b[1]), pk2(b[2], b[3])};
            }
        };
        conv(p.x, WS_PTR(bf16_t, OFF_XB0), (size_t)T_TOK * DM / 8);
        conv(p.mem, WS_PTR(bf16_t, OFF_MEMB), (size_t)4096 * DM / 8);
    }
}

DI void signal_done(unsigned* c) {
    wait_vm<0>();
    __syncthreads();
    if (threadIdx.x == 0) { __builtin_amdgcn_fence(__ATOMIC_RELEASE, "agent"); __hip_atomic_fetch_add(c, 1u, __ATOMIC_RELAXED, __HIP_MEMORY_SCOPE_AGENT); }
}
DI void wait_count(unsigned* c, unsigned need) {
    if (threadIdx.x == 0) {
        while (__hip_atomic_load(c, __ATOMIC_RELAXED, __HIP_MEMORY_SCOPE_AGENT) < need) __builtin_amdgcn_s_sleep(1);
        __builtin_amdgcn_fence(__ATOMIC_ACQUIRE, "agent");
    }
    __syncthreads();
}

DI void unit_KV(const Params& p, char* lds, int l, int mtile, int q) {
    const int tid = opaque_tid(), lane = tid & 63, wid = tid >> 6, wr = wid >> 2, wc = wid & 3, l15 = lane & 15, quad = lane >> 4;
    f32x4 acc[4][2];
    gemm_main<128, 128, 2, 4, 1, true, 3>(WS_PTR(const bf16_t, OFF_MEMB) + (size_t)mtile * 128 * 1024, WS_PTR(const bf16_t, OFF_WKV) + (size_t)l * 524288 + (size_t)(128 * q) * 32, 512 * 32, lds, acc);
    bf16_t* Kb = WS_PTR(bf16_t, OFF_KB) + (size_t)l * 4096 * 256;
    bf16_t* Vp = WS_PTR(bf16_t, OFF_VP) + (size_t)l * 4096 * 256;
#pragma unroll
    for (int mt = 0; mt < 4; ++mt) {
        const int r = mtile * 128 + wr * 64 + mt * 16 + l15, b = r >> 8, m = r & 255;
#pragma unroll
        for (int nt = 0; nt < 2; ++nt) {
            const int col = 128 * q + wc * 32 + nt * 16 + quad * 4;
            const f32x4 v = acc[mt][nt];
            if (q < 2) {
                const int head = col >> 6, d = col & 63;
                *(u32x2*)(Kb + ((size_t)((b * 4 + head) * 256 + m)) * 64 + d) = (u32x2){pk2(v[0], v[1]), pk2(v[2], v[3])};
            } else {
                const int cv = col - 256, head = cv >> 6, d = cv & 63;
                const int rr = m & 31, pos = (m & ~31) + 8 * ((rr >> 2) & 3) + 4 * (rr >> 4) + (rr & 3);
#pragma unroll
                for (int i = 0; i < 4; ++i) Vp[((size_t)((b * 4 + head) * 64 + d + i)) * 256 + pos] = (bf16_t)bf16_bits(v[i]);
            }
        }
    }
    signal_done(WS_PTR(unsigned, OFF_HL) + 64 + l * 16 + (mtile >> 1));
}

template <int CTRL> DI float dpp_f(float v) { return __builtin_bit_cast(float, __builtin_amdgcn_update_dpp(0, __builtin_bit_cast(int, v), CTRL, 0xF, 0xF, true)); }
DI float row16_sum(float v) {
    v += dpp_f<0xB1>(v);
    v += dpp_f<0x4E>(v);
    v += dpp_f<0x141>(v);
    v += dpp_f<0x140>(v);
    return v;
}

DI void unit_A(const Params& p, char* lds, int l, int chunk, int h) {
    const int tid = opaque_tid(), lane = tid & 63, wid = tid >> 6, wr = wid >> 2, wc = wid & 3, l15 = lane & 15, quad = lane >> 4;
    f32x4 acc[4][6];
    const bf16_t* xb = WS_PTR(const bf16_t, l == 0 ? OFF_XB0 : OFF_XB1);
    char* WL = lds + 98304;
    __syncthreads();
    {
        const bf16_t* W = WS_PTR(const bf16_t, OFF_WSP) + (size_t)(l * 4 + h) * 16384;
#pragma unroll
        for (int i = 0; i < 4; ++i) {
            const int piece = wid + 8 * i, row = piece * 4 + (lane >> 4), lc = (lane & 15) ^ (row & 15);
            __builtin_amdgcn_global_load_lds((const unsigned*)(W + row * 128 + lc * 8), (unsigned*)(WL + piece * 1024 + lane * 16), 16, 0, 0);
        }
    }
    gemm_main<128, 384, 2, 4, 3, false, 3>(xb + (size_t)chunk * 128 * 1024, WS_PTR(const bf16_t, OFF_WIN) + (size_t)l * 2560 * 1024 + (size_t)h * 384 * 32, 2560 * 32, lds, acc);
    float* stat = (float*)lds;
    char* Vt = lds + 4096;
    float lgv[2], lbv[2];
#pragma unroll
    for (int n2 = 0; n2 < 2; ++n2) { const int d = wc * 32 + n2 * 16 + l15; lgv[n2] = p.gm_ln_g[(l * 4 + h) * 128 + d]; lbv[n2] = p.gm_ln_b[(l * 4 + h) * 128 + d]; }
    f32x4 bsv[4];
#pragma unroll
    for (int mt = 0; mt < 4; ++mt) bsv[mt] = *(const f32x4*)(p.gm_b_s + (l * 4 + h) * 128 + wr * 64 + mt * 16 + quad * 4);
    {
        float sv[4][4], ssv[4][4];
#pragma unroll
        for (int mt = 0; mt < 4; ++mt)
#pragma unroll
            for (int i = 0; i < 4; ++i) {
                float s = 0.f, ss = 0.f;
#pragma unroll
                for (int n2 = 0; n2 < 2; ++n2) { const float v = gelu_f(acc[mt][2 + n2][i]); acc[mt][2 + n2][i] = v; s += v; ss += v * v; }
                sv[mt][i] = s; ssv[mt][i] = ss;
            }
#pragma unroll
        for (int mt = 0; mt < 4; ++mt)
#pragma unroll
            for (int i = 0; i < 4; ++i) { sv[mt][i] = row16_sum(sv[mt][i]); ssv[mt][i] = row16_sum(ssv[mt][i]); }
        if (l15 == 0) {
#pragma unroll
            for (int mt = 0; mt < 4; ++mt)
#pragma unroll
                for (int i = 0; i < 4; ++i) { const int row = wr * 64 + mt * 16 + quad * 4 + i; *(f32x2*)&stat[(row * 4 + wc) * 2] = (f32x2){sv[mt][i], ssv[mt][i]}; }
        }
    }
    __syncthreads();
#pragma unroll
    for (int mt = 0; mt < 4; ++mt) {
        float mu[4], rs[4];
#pragma unroll
        for (int i = 0; i < 4; ++i) {
            const int row = wr * 64 + mt * 16 + quad * 4 + i;
            const f32x4 a = *(const f32x4*)&stat[row * 8], b = *(const f32x4*)&stat[row * 8 + 4];
            const float s = (a[0] + a[2]) + (b[0] + b[2]), ss = (a[1] + a[3]) + (b[1] + b[3]);
            mu[i] = s * (1.f / 128.f);
            const float var = ss * (1.f / 128.f) - mu[i] * mu[i];
            rs[i] = rsqrtf(var + LN_EPS);
        }
#pragma unroll
        for (int n2 = 0; n2 < 2; ++n2) {
            const int d = wc * 32 + n2 * 16 + l15;
            float v[4];
#pragma unroll
            for (int i = 0; i < 4; ++i) v[i] = (acc[mt][2 + n2][i] - mu[i]) * rs[i] * lgv[n2] + lbv[n2];
            *(u32x2*)(Vt + d * 272 + (wr * 64 + mt * 16 + quad * 4) * 2) = (u32x2){pk2(v[0], v[1]), pk2(v[2], v[3])};
        }
    }
    __syncthreads();
    f32x4 mx[4][2];
#pragma unroll
    for (int mt = 0; mt < 4; ++mt) { mx[mt][0] = (f32x4){0.f, 0.f, 0.f, 0.f}; mx[mt][1] = (f32x4){0.f, 0.f, 0.f, 0.f}; }
#pragma unroll
    for (int ks = 0; ks < 4; ++ks) {
        if (32 * ks <= 64 * wr + 63) {
            bf16x8 bv[2];
#pragma unroll
            for (int n2 = 0; n2 < 2; ++n2) bv[n2] = *(const bf16x8*)(Vt + (wc * 32 + n2 * 16 + l15) * 272 + (32 * ks + 8 * quad) * 2);
#pragma unroll
            for (int mt = 0; mt < 4; ++mt) {
                if (32 * ks <= 64 * wr + 16 * mt + 15) {
                    const bf16x8 aw = *(const bf16x8*)(WL + (wr * 64 + mt * 16 + l15) * 256 + (((4 * ks + quad) ^ l15) << 4));
                    mx[mt][0] = mfma16(aw, bv[0], mx[mt][0]);
                    mx[mt][1] = mfma16(aw, bv[1], mx[mt][1]);
                }
            }
        }
    }
    bf16_t* yo = WS_PTR(bf16_t, OFF_Y) + ((size_t)((chunk * 2 + wr) * 32 + 4 * h + wc) * 64 + quad * 4) * 32 + l15;
#pragma unroll
    for (int mt = 0; mt < 4; ++mt)
#pragma unroll
        for (int i = 0; i < 4; ++i) {
            const float b = bsv[mt][i];
#pragma unroll
            for (int n2 = 0; n2 < 2; ++n2) {
                const float val = gelu_f(acc[mt][n2][i]) * (mx[mt][n2][i] + b) * silu_f(acc[mt][4 + n2][i]);
                yo[(mt * 16 + i) * 32 + n2 * 16] = (bf16_t)bf16_bits(val);
            }
        }
}

#ifndef PROBE_DBG
#define PROBE_DBG -1
#endif
template <int DBG>
DI void unit_A_dummy(const Params& p, char* lds, int l, int chunk, int h) {
    f32x4 acc[4][6];
    const bf16_t* xb = WS_PTR(const bf16_t, l == 0 ? OFF_XB0 : OFF_XB1);
    gemm_main<128, 384, 2, 4, 3, false, 3, DBG>(xb + (size_t)chunk * 128 * 1024, WS_PTR(const bf16_t, OFF_WIN) + (size_t)l * 2560 * 1024 + (size_t)h * 384 * 32, 2560 * 32, lds, acc);
    float s = 0.f;
#pragma unroll
    for (int mt = 0; mt < 4; ++mt)
#pragma unroll
        for (int nt = 0; nt < 6; ++nt) s += acc[mt][nt][0] + acc[mt][nt][1] + acc[mt][nt][2] + acc[mt][nt][3];
    if (s == 123456.789f) WS_PTR(float, OFF_HL)[0] = s;
}

DI void unit_B1(const Params& p, char* lds, int l, int chunk) {
    const int tid = opaque_tid(), lane = tid & 63, wid = tid >> 6, wr = wid >> 2, wc = wid & 3, l15 = lane & 15, quad = lane >> 4;
    const bf16_t* xb = WS_PTR(const bf16_t, l == 0 ? OFF_XB0 : OFF_XB1);
    f32x4 acc[4][8];
    gemm_main<128, 512, 2, 4, 1, true, 3>(xb + (size_t)chunk * 128 * 1024, WS_PTR(const bf16_t, OFF_WIN) + (size_t)l * 2560 * 1024 + (size_t)1536 * 32, 2560 * 32, lds, acc);
    bf16_t* sgd = WS_PTR(bf16_t, OFF_SG) + (size_t)chunk * 128 * 256;
    bf16_t* xbd = WS_PTR(bf16_t, OFF_XBB) + (size_t)(chunk >> 4) * 16 * 2048 * 16;
#pragma unroll
    for (int mt = 0; mt < 4; ++mt) {
        const int tok = wr * 64 + mt * 16 + l15;
#pragma unroll
        for (int nt = 0; nt < 8; ++nt) {
            f32x4 v = acc[mt][nt];
            if (wc >= 2) {
                v[0] = silu_f(v[0]); v[1] = silu_f(v[1]); v[2] = silu_f(v[2]); v[3] = silu_f(v[3]);
                const int col = (wc & 1) * 128 + nt * 16 + quad * 4;
                *(u32x2*)(sgd + (size_t)tok * 256 + col) = (u32x2){pk2(v[0], v[1]), pk2(v[2], v[3])};
            } else {
                const int g = (wc & 1) * 8 + nt, tb = (chunk & 15) * 128 + tok;
                *(u32x2*)(xbd + ((size_t)g * 2048 + tb) * 16 + quad * 4) = (u32x2){pk2(v[0], v[1]), pk2(v[2], v[3])};
            }
        }
    }
    signal_done(WS_PTR(unsigned, OFF_HL) + 128 + l * 16 + (chunk >> 4));
}

DI void unit_S5(const Params& p, char* lds, int l, int b, int g) {
    const int tid = opaque_tid(), lane = tid & 63, wid = tid >> 6, l15 = lane & 15, quad = lane >> 4;
    const int lg = l * 16 + g;
    const bf16_t* T = WS_PTR(const bf16_t, OFF_S5T) + (size_t)lg * 3 * 16384;
    float* HLb = (float*)lds;
    float* EndS = (float*)(lds + 67584);
    bf16x8 wst[4], wintra[4], wcar[4];
#pragma unroll
    for (int ks = 0; ks < 4; ++ks) {
        wintra[ks] = *(const bf16x8*)(T + (16 * wid + l15) * 128 + 32 * ks + 8 * quad);
        wst[ks] = *(const bf16x8*)(T + 16384 + (16 * wid + l15) * 128 + 32 * ks + 8 * quad);
        wcar[ks] = *(const bf16x8*)(T + 32768 + (16 * wid + l15) * 128 + 32 * ks + 8 * quad);
    }
    const f32x2 L8 = WS_PTR(const f32x2, OFF_L8)[lg * 64 + lane], L128 = WS_PTR(const f32x2, OFF_L128)[lg * 64 + lane];
    const bf16_t* Xg = WS_PTR(const bf16_t, OFF_XBB) + ((size_t)(b * 16 + g) * 2048) * 16;
    bf16_t* YSo = WS_PTR(bf16_t, OFF_YS) + (size_t)b * 2048 * 256 + 16 * g;
    const float dsk = p.ssm_d[l * 256 + 16 * g + l15];
    char* Xl = lds + 75776;
    __syncthreads();
    wait_count(WS_PTR(unsigned, OFF_HL) + 128 + l * 16 + b, 16u);
#pragma unroll
    for (int i = 0; i < 8; ++i) {
        const int P = (wid * 8 + i) * 64 + lane, S = P ^ ((P >> 4) & 15);
        __builtin_amdgcn_global_load_lds((const unsigned*)(Xg + (size_t)S * 8), (unsigned*)(Xl + P * 16), 16, 0, 0);
    }
    wait_vm<0>();
    __syncthreads();
    auto xfrag = [&](int c, int ks) -> bf16x8 {
        const int tok = 128 * c + 8 * l15 + 2 * ks + (quad >> 1), S = tok * 2 + (quad & 1);
        return *(const bf16x8*)(Xl + ((S ^ ((S >> 4) & 15)) << 4));
    };
    for (int half = 0; half < 2; ++half) {
#pragma unroll 2
        for (int cl = 0; cl < 8; ++cl) {
            const int c = half * 8 + cl;
            f32x4 hl = (f32x4){0.f, 0.f, 0.f, 0.f};
#pragma unroll
            for (int ks = 0; ks < 4; ++ks) {
                const bf16x8 xa = xfrag(c, ks);
                hl = mfma16(xa, wst[ks], hl);
            }
#pragma unroll
            for (int i = 0; i < 4; ++i) HLb[cl * 2112 + (4 * quad + i) * 132 + 16 * wid + l15] = hl[i];
        }
        __syncthreads();
        {
            float* H = HLb + wid * 2112;
            float ar[16], ai[16];
#pragma unroll
            for (int j = 0; j < 16; ++j) { ar[j] = H[j * 132 + lane]; ai[j] = H[j * 132 + 64 + lane]; }
            float hr = 0.f, hi = 0.f;
#pragma unroll
            for (int j = 0; j < 16; ++j) {
                const float pr = hr, pi = hi;
                const float nr = L8.x * hr - L8.y * hi + ar[j], ni = L8.x * hi + L8.y * hr + ai[j];
                hr = nr; hi = ni;
                H[j * 132 + lane] = pr; H[j * 132 + 64 + lane] = pi;
            }
            EndS[(half * 8 + wid) * 128 + lane] = hr;
            EndS[(half * 8 + wid) * 128 + 64 + lane] = hi;
        }
        __syncthreads();
        {
            const int c = half * 8 + wid;
            float er[15], ei[15];
#pragma unroll
            for (int cc = 0; cc < 15; ++cc) { er[cc] = (cc < c) ? EndS[cc * 128 + lane] : 0.f; ei[cc] = (cc < c) ? EndS[cc * 128 + 64 + lane] : 0.f; }
            float* H = HLb + wid * 2112;
            float fr[16], fi[16];
#pragma unroll
            for (int j = 0; j < 16; ++j) { fr[j] = H[j * 132 + lane]; fi[j] = H[j * 132 + 64 + lane]; }
            float hr = 0.f, hi = 0.f;
#pragma unroll
            for (int cc = 0; cc < 15; ++cc) {
                if (cc < c) { const float nr = L128.x * hr - L128.y * hi + er[cc], ni = L128.x * hi + L128.y * hr + ei[cc]; hr = nr; hi = ni; }
            }
            asm volatile("s_waitcnt lgkmcnt(0)" ::: "memory");
#pragma unroll
            for (int j = 0; j < 16; ++j) {
                bf16_t* hp = (bf16_t*)(H + j * 132);
                hp[lane] = (bf16_t)bf16_bits(fr[j] + hr);
                hp[64 + lane] = (bf16_t)bf16_bits(fi[j] + hi);
                const float nr = L8.x * hr - L8.y * hi, ni = L8.x * hi + L8.y * hr;
                hr = nr; hi = ni;
            }
        }
        __syncthreads();
#pragma unroll 2
        for (int cl = 0; cl < 8; ++cl) {
            const int c = half * 8 + cl;
            const char* H = (const char*)(HLb + cl * 2112);
            f32x4 y = (f32x4){0.f, 0.f, 0.f, 0.f};
#pragma unroll
            for (int ks = 0; ks < 4; ++ks) {
                const bf16x8 xa = xfrag(c, ks);
                y = mfma16(xa, wintra[ks], y);
            }
#pragma unroll
            for (int ks = 0; ks < 4; ++ks) {
                const bf16x8 hp = *(const bf16x8*)(H + l15 * 528 + (32 * ks + 8 * quad) * 2);
                y = mfma16(hp, wcar[ks], y);
            }
#pragma unroll
            for (int i = 0; i < 4; ++i) {
                const int tokl = 128 * c + 8 * (4 * quad + i) + wid;
                const int S = tokl * 2 + (l15 >> 3);
                const float xv = bf2f(*(const bf16_t*)(Xl + ((S ^ ((S >> 4) & 15)) << 4) + (l15 & 7) * 2));
                YSo[(size_t)tokl * 256 + l15] = (bf16_t)bf16_bits(gelu_f(y[i] + dsk * xv));
            }
        }
        __syncthreads();
    }
}

DI void glu_prologue(const Params& p, char* lds, int l, int tile) {
    const int tid = opaque_tid(), lane = tid & 63, wid = tid >> 6, l15 = lane & 15, quad = lane >> 4;
    char* Ys = lds;
    const bf16_t* ysg = WS_PTR(const bf16_t, OFF_YS) + (size_t)tile * 64 * 256;
    __syncthreads();
#pragma unroll
    for (int i = 0; i < 4; ++i) {
        const int idx = tid + NTHR * i, row = idx >> 5, c16 = idx & 31;
        *(u32x4*)(Ys + row * 528 + c16 * 16) = *(const u32x4*)(ysg + (size_t)row * 256 + c16 * 8);
    }
    __syncthreads();
    f32x4 acc[4][2];
#pragma unroll
    for (int mt = 0; mt < 4; ++mt) { acc[mt][0] = (f32x4){0.f, 0.f, 0.f, 0.f}; acc[mt][1] = (f32x4){0.f, 0.f, 0.f, 0.f}; }
    const bf16_t* Wg = WS_PTR(const bf16_t, OFF_WGLU) + (size_t)l * 65536;
#pragma unroll 2
    for (int ks = 0; ks < 8; ++ks) {
        bf16x8 a[4], bb[2];
#pragma unroll
        for (int mt = 0; mt < 4; ++mt) a[mt] = *(const bf16x8*)(Ys + (mt * 16 + l15) * 528 + (32 * ks + 8 * quad) * 2);
#pragma unroll
        for (int nt = 0; nt < 2; ++nt) bb[nt] = *(const bf16x8*)(Wg + (wid * 32 + nt * 16 + l15) * 256 + 32 * ks + 8 * quad);
#pragma unroll
        for (int mt = 0; mt < 4; ++mt)
#pragma unroll
            for (int nt = 0; nt < 2; ++nt) acc[mt][nt] = mfma16(bb[nt], a[mt], acc[mt][nt]);
    }
    const bf16_t* sg = WS_PTR(const bf16_t, OFF_SG) + (size_t)tile * 64 * 256;
    bf16_t* yo = WS_PTR(bf16_t, OFF_Y);
#pragma unroll
    for (int mt = 0; mt < 4; ++mt) {
        const int tok = mt * 16 + l15;
#pragma unroll
        for (int nt = 0; nt < 2; ++nt) {
            const int n0 = wid * 32 + nt * 16 + quad * 4;
            const f32x4 gb = *(const f32x4*)(p.glu_b + l * 256 + n0);
            const u32x2 yv = *(const u32x2*)(Ys + tok * 528 + n0 * 2);
            const u32x2 sv = *(const u32x2*)(sg + (size_t)tok * 256 + n0);
            float o[4];
            o[0] = sigmoid_f(acc[mt][nt][0] + gb[0]) * bf2f(yv[0] & 0xffffu) * bf2f(sv[0] & 0xffffu);
            o[1] = sigmoid_f(acc[mt][nt][1] + gb[1]) * bf2f(yv[0] >> 16) * bf2f(sv[0] >> 16);
            o[2] = sigmoid_f(acc[mt][nt][2] + gb[2]) * bf2f(yv[1] & 0xffffu) * bf2f(sv[1] & 0xffffu);
            o[3] = sigmoid_f(acc[mt][nt][3] + gb[3]) * bf2f(yv[1] >> 16) * bf2f(sv[1] >> 16);
            *(u32x2*)(yo + y_off(tile * 64 + tok, 512 + n0)) = (u32x2){pk2(o[0], o[1]), pk2(o[2], o[3])};
        }
    }
    wait_vm<0>();
}

DI void unit_X(const Params& p, char* lds, int l, int chunk) {
    const int tid = opaque_tid(), lane = tid & 63, wid = tid >> 6, wr = wid >> 2, wc = wid & 3, l15 = lane & 15, quad = lane >> 4;
    const bf16_t* xb = WS_PTR(const bf16_t, l == 0 ? OFF_XB0 : OFF_XB1);
    char* Qs = lds;
    bf16_t* gx = WS_PTR(bf16_t, OFF_GX) + (size_t)chunk * 128 * 256;
    {
        f32x4 acc[4][8];
        gemm_main<128, 512, 2, 4, 1, true, 3>(xb + (size_t)chunk * 128 * 1024, WS_PTR(const bf16_t, OFF_WIN) + (size_t)l * 2560 * 1024 + (size_t)2048 * 32, 2560 * 32, lds, acc);
#pragma unroll
        for (int mt = 0; mt < 4; ++mt) {
            const int tok = wr * 64 + mt * 16 + l15;
#pragma unroll
            for (int nt = 0; nt < 8; ++nt) {
                const f32x4 v = acc[mt][nt];
                if (wc < 2) {
                    const int col = wc * 128 + nt * 16 + quad * 4;
                    const float qs = 0.125f * 1.44269504089f;
                    *(u32x2*)(Qs + tok * 528 + col * 2) = (u32x2){pk2(v[0] * qs, v[1] * qs), pk2(v[2] * qs, v[3] * qs)};
                } else {
                    const int col = (wc - 2) * 128 + nt * 16 + quad * 4;
                    *(u32x2*)(gx + (size_t)tok * 256 + col) = (u32x2){pk2(silu_f(v[0]), silu_f(v[1])), pk2(silu_f(v[2]), silu_f(v[3]))};
                }
            }
        }
    }
    __syncthreads();
    bf16x8 bq[4][2];
#pragma unroll
    for (int h = 0; h < 4; ++h)
#pragma unroll
        for (int ks = 0; ks < 2; ++ks) bq[h][ks] = *(const bf16x8*)(Qs + (wid * 16 + l15) * 528 + (64 * h + 32 * ks + 8 * quad) * 2);
    const int b = chunk >> 4;
    if (l == 0) wait_count(WS_PTR(unsigned, OFF_HL) + 64 + l * 16 + b, 8u); else __syncthreads();
    const bf16_t* Kb = WS_PTR(const bf16_t, OFF_KB) + (size_t)l * 4096 * 256 + (size_t)(b * 4) * 256 * 64;
    const bf16_t* Vb = WS_PTR(const bf16_t, OFF_VP) + (size_t)l * 4096 * 256 + (size_t)(b * 4) * 64 * 256;
    bf16_t* yo = WS_PTR(bf16_t, OFF_Y);
    auto issue_kv = [&](int h, int buf) {
        const bf16_t* Kh = Kb + (size_t)h * 256 * 64;
        const bf16_t* Vh = Vb + (size_t)h * 64 * 256;
        char* kd = lds + buf * 65536;
        char* vd = kd + 32768;
#pragma unroll
        for (int i = 0; i < 4; ++i) {
            const int piece = wid + 8 * i;
            {
                const int row = piece * 8 + (lane >> 3), lc = (lane & 7) ^ ((row >> 1) & 7);
                __builtin_amdgcn_global_load_lds((const unsigned*)(Kh + row * 64 + lc * 8), (unsigned*)(kd + piece * 1024 + lane * 16), 16, 0, 0);
            }
            {
                const int row = piece * 2 + (lane >> 5), lc = (lane & 31) ^ (row & 15);
                __builtin_amdgcn_global_load_lds((const unsigned*)(Vh + row * 256 + lc * 8), (unsigned*)(vd + piece * 1024 + lane * 16), 16, 0, 0);
            }
        }
    };
    issue_kv(0, 0);
    const int tok = wid * 16 + l15;
#pragma unroll
    for (int h = 0; h < 4; ++h) {
        wait_vm<0>();
        raw_barrier();
        if (h < 3) issue_kv(h + 1, (h + 1) & 1);
        const char* kd = lds + (h & 1) * 65536;
        const char* vd = kd + 32768;
        f32x4 s[16];
#pragma unroll
        for (int mt = 0; mt < 16; ++mt) s[mt] = (f32x4){0.f, 0.f, 0.f, 0.f};
#pragma unroll
        for (int ks = 0; ks < 2; ++ks) {
#pragma unroll
            for (int mt = 0; mt < 16; ++mt) {
                const int row = 16 * mt + l15;
                const bf16x8 ak = *(const bf16x8*)(kd + row * 128 + (((4 * ks + quad) ^ ((row >> 1) & 7)) << 4));
                s[mt] = mfma16(ak, bq[h][ks], s[mt]);
            }
        }
        float mxv = -3.0e38f;
#pragma unroll
        for (int mt = 0; mt < 16; ++mt)
#pragma unroll
            for (int i = 0; i < 4; ++i) mxv = fmaxf(mxv, s[mt][i]);
        mxv = fmaxf(mxv, __shfl_xor(mxv, 16));
        mxv = fmaxf(mxv, __shfl_xor(mxv, 32));
        float sum = 0.f;
#pragma unroll
        for (int mt = 0; mt < 16; ++mt)
#pragma unroll
            for (int i = 0; i < 4; ++i) { const float e = __builtin_amdgcn_exp2f(s[mt][i] - mxv); s[mt][i] = e; sum += e; }
        sum += __shfl_xor(sum, 16);
        sum += __shfl_xor(sum, 32);
        const float inv = 1.f / sum;
        f32x4 o[4];
#pragma unroll
        for (int dt = 0; dt < 4; ++dt) o[dt] = (f32x4){0.f, 0.f, 0.f, 0.f};
#pragma unroll
        for (int ks = 0; ks < 8; ++ks) {
            const f32x4 a = s[2 * ks], c = s[2 * ks + 1];
            const u32x4 w = (u32x4){pk2(a[0], a[1]), pk2(a[2], a[3]), pk2(c[0], c[1]), pk2(c[2], c[3])};
            const bf16x8 pb = __builtin_bit_cast(bf16x8, w);
#pragma unroll
            for (int dt = 0; dt < 4; ++dt) {
                const int row = 16 * dt + l15;
                const bf16x8 av = *(const bf16x8*)(vd + row * 512 + (((4 * ks + quad) ^ (row & 15)) << 4));
                o[dt] = mfma16(av, pb, o[dt]);
            }
        }
#pragma unroll
        for (int dt = 0; dt < 4; ++dt) {
            const int d = 16 * dt + 4 * quad;
            const u32x2 gv = *(const u32x2*)(gx + (size_t)tok * 256 + 64 * h + d);
            const float o0 = o[dt][0] * inv * bf2f(gv[0] & 0xffffu), o1 = o[dt][1] * inv * bf2f(gv[0] >> 16);
            const float o2 = o[dt][2] * inv * bf2f(gv[1] & 0xffffu), o3 = o[dt][3] * inv * bf2f(gv[1] >> 16);
            *(u32x2*)(yo + y_off(chunk * 128 + tok, 768 + h * 64 + d)) = (u32x2){pk2(o0, o1), pk2(o2, o3)};
        }
    }
}

DI void unit_O(const Params& p, char* lds, int l, int tile) {
    const int tid = opaque_tid(), lane = tid & 63, wid = tid >> 6, l15 = lane & 15, quad = lane >> 4;
    glu_prologue(p, lds, l, tile);
    f32x4 acc[4][8];
    gemm_main<64, 1024, 1, 8, 1, true, 2>(WS_PTR(const bf16_t, OFF_Y) + (size_t)tile * 64 * 1024, WS_PTR(const bf16_t, OFF_WOUT) + (size_t)l * 1024 * 1024, 1024 * 32, lds, acc);
    const float* xres = (l == 0) ? p.x : WS_PTR(const float, OFF_X1);
    const size_t r0 = (size_t)tile * 64;
    char* XR = lds;
    float* GB = (float*)(lds + 131072);
    float* red = (float*)(lds + 139264);
    const int xrot = (int)(((blockIdx.x >> 3) + (blockIdx.x & 7) * 4) & 31) * 4;
    const bf16_t* xbres = WS_PTR(const bf16_t, OFF_XB1) + ((size_t)((tile >> 1) * 32) * 128 + (tile & 1) * 64) * 32;
    auto issue_x = [&](int half) {
        if (l == 0) {
#pragma unroll 1
            for (int i = 0; i < 16; ++i) {
                const int pc = (wid * 16 + i + xrot) & 127, row = pc >> 2, phys = (pc & 3) * 64 + lane, logical = phys ^ (row & 15);
                __builtin_amdgcn_global_load_lds((const unsigned*)(xres + (r0 + half * 32 + row) * 1024 + logical * 4), (unsigned*)(XR + pc * 1024 + lane * 16), 16, 0, 0);
            }
        } else {
#pragma unroll 1
            for (int i = 0; i < 8; ++i) {
                const int pc = (wid * 8 + i + (xrot >> 1)) & 63, kt = pc >> 1, sub = pc & 1;
                __builtin_amdgcn_global_load_lds((const unsigned*)(xbres + ((size_t)kt * 128 + half * 32) * 32 + sub * 512 + lane * 8), (unsigned*)(XR + half * 65536 + pc * 1024 + lane * 16), 16, 0, 0);
            }
        }
    };
    issue_x(0);
    if (l == 1) issue_x(1);
    {
        const float* gsrc = (tid < 256) ? (p.ln_g + l * 1024 + tid * 4) : (p.ln_b + l * 1024 + (tid - 256) * 4);
        *(f32x4*)(GB + tid * 4) = *(const f32x4*)gsrc;
    }
    float* xo = (l == 0) ? WS_PTR(float, OFF_X1) : p.out;
    bf16_t* xbo = WS_PTR(bf16_t, OFF_XB1);
#pragma unroll
    for (int half = 0; half < 2; ++half) {
        if (half == 0) wait_vm<0>();
        else wait_vm<8>();
        __syncthreads();
        float s2[2], ss2[2];
#pragma unroll
        for (int mh = 0; mh < 2; ++mh) {
            const int mt = half * 2 + mh, rl = mh * 16 + l15;
            float s = 0.f, ss = 0.f;
#pragma unroll
            for (int nt = 0; nt < 8; ++nt) {
                f32x4 xr;
                if (l == 0) {
                    const int chunk = wid * 32 + nt * 4 + quad;
                    xr = *(const f32x4*)(XR + rl * 4096 + ((chunk ^ l15) << 4));
                } else {
                    const u32x2 hb = *(const u32x2*)(XR + half * 65536 + ((wid * 4 + (nt >> 1)) * 32 + rl) * 64 + (nt & 1) * 32 + quad * 8);
                    xr = (f32x4){bf2f(hb[0] & 0xffffu), bf2f(hb[0] >> 16), bf2f(hb[1] & 0xffffu), bf2f(hb[1] >> 16)};
                }
#pragma unroll
                for (int i = 0; i < 4; ++i) { const float v = acc[mt][nt][i] + DN_ALPHA * xr[i]; acc[mt][nt][i] = v; s += v; ss += v * v; }
            }
            s2[mh] = s; ss2[mh] = ss;
        }
#pragma unroll
        for (int mh = 0; mh < 2; ++mh) { s2[mh] += __shfl_xor(s2[mh], 16); ss2[mh] += __shfl_xor(ss2[mh], 16); }
#pragma unroll
        for (int mh = 0; mh < 2; ++mh) { s2[mh] += __shfl_xor(s2[mh], 32); ss2[mh] += __shfl_xor(ss2[mh], 32); }
        if (quad == 0) {
#pragma unroll
            for (int mh = 0; mh < 2; ++mh) *(f32x2*)&red[((mh * 16 + l15) * 8 + wid) * 2] = (f32x2){s2[mh], ss2[mh]};
        }
        __syncthreads();
        if (half == 0 && l == 0) issue_x(1);
#pragma unroll
        for (int mh = 0; mh < 2; ++mh) {
            const int mt = half * 2 + mh, rl = mh * 16 + l15, row = mt * 16 + l15;
            float s = 0.f, ss = 0.f;
#pragma unroll
            for (int w = 0; w < 4; ++w) { const f32x4 v = *(const f32x4*)&red[rl * 16 + 4 * w]; s += v[0] + v[2]; ss += v[1] + v[3]; }
            const float mu = s * (1.f / 1024.f);
            const float var = ss * (1.f / 1024.f) - mu * mu;
            const float rs = rsqrtf(var + LN_EPS);
            float* orow = xo + (r0 + row) * 1024 + wid * 128 + quad * 4;
            bf16_t* brow = xbo + xb_off((int)r0 + row, wid * 128) + quad * 4;
            const float* gp = GB + wid * 128 + quad * 4;
#pragma unroll
            for (int nt = 0; nt < 8; ++nt) {
                const f32x4 g = *(const f32x4*)(gp + nt * 16), bb = *(const f32x4*)(gp + 1024 + nt * 16);
                f32x4 o;
#pragma unroll
                for (int i = 0; i < 4; ++i) o[i] = (acc[mt][nt][i] - mu) * rs * g[i] + bb[i];
                if (l == 0) *(u32x2*)(brow + (nt >> 1) * 4096 + (nt & 1) * 16) = (u32x2){pk2(o[0], o[1]), pk2(o[2], o[3])};
                else *(f32x4*)(orow + nt * 16) = o;
            }
        }
    }
}

DI void fast_grid_barrier(unsigned* ctr, unsigned target) {
    wait_vm<0>();
    __syncthreads();
    if (threadIdx.x == 0) {
        __builtin_amdgcn_fence(__ATOMIC_RELEASE, "agent");
        __hip_atomic_fetch_add(ctr, 1u, __ATOMIC_RELAXED, __HIP_MEMORY_SCOPE_AGENT);
        while (__hip_atomic_load(ctr, __ATOMIC_RELAXED, __HIP_MEMORY_SCOPE_AGENT) < target) __builtin_amdgcn_s_sleep(1);
        __builtin_amdgcn_fence(__ATOMIC_ACQUIRE, "agent");
    }
    __syncthreads();
}

__global__ void __launch_bounds__(NTHR) mega_fwd(Params p) {
    extern __shared__ __attribute__((aligned(16))) char lds[];
    cg::grid_group grid = cg::this_grid();
    const int nb = gridDim.x, bid = blockIdx.x;
    if (bid == 0 && threadIdx.x < 256) __hip_atomic_store(WS_PTR(unsigned, OFF_HL) + threadIdx.x, 0u, __ATOMIC_RELAXED, __HIP_MEMORY_SCOPE_AGENT);
    prep_phase(p, lds);
    unsigned* bar = WS_PTR(unsigned, OFF_HL);
    for (int ph = 0; ph < 4; ++ph) {
        if (ph == 0) grid.sync(); else fast_grid_barrier(bar, (unsigned)ph * (unsigned)nb);
        const int l = ph >> 1;
        if ((ph & 1) == 0) {
            const int nkv = (l == 0) ? 256 : 0, nunits = 256 + nkv + 1024 + 256 + 256;
            for (int u = bid; u < nunits; u += nb) {
                int v = u;
                if (v < 256) { unit_B1(p, lds, l, v); continue; }
                v -= 256;
                if (v < nkv) { unit_KV(p, lds, v >> 7, (v >> 2) & 31, v & 3); continue; }
                v -= nkv;
                if (v < 1024) { unit_A(p, lds, l, v & 255, v >> 8); continue; }
                v -= 1024;
                const int s = v & 255, xcd = s & 7, i = s >> 3;
                if (v < 256) unit_X(p, lds, l, xcd * 32 + i);
                else unit_S5(p, lds, l, xcd * 2 + (i >> 4), i & 15);
            }
        } else {
            for (int u = bid; u < 512; u += nb) unit_O(p, lds, l, u);
        }
    }
}

extern "C" void kernel_launch(void* const* d_in, const int* in_sizes, int n_in, void* d_out, int out_size, void* d_ws, size_t ws_size, hipStream_t stream) {
    static int grid_blocks = 0;
    if (!grid_blocks) {
        int dev = 0, cus = 0, per_cu = 0;
        hipGetDevice(&dev);
        hipDeviceGetAttribute(&cus, hipDeviceAttributeMultiprocessorCount, dev);
        hipFuncSetAttribute((const void*)mega_fwd, hipFuncAttributeMaxDynamicSharedMemorySize, LDS_BYTES);
        hipOccupancyMaxActiveBlocksPerMultiprocessor(&per_cu, mega_fwd, NTHR, LDS_BYTES);
        if (per_cu < 1) per_cu = 1;
        grid_blocks = cus * per_cu;
        if (grid_blocks > 256) grid_blocks = 256;
    }
    Params p{};
    const float** pp = (const float**)&p;
    for (int i = 0; i < 22; ++i) pp[i] = (const float*)d_in[i];
    p.out = (float*)d_out;
    p.ws = (char*)d_ws;
    void* args[] = {&p};
    hipError_t e = hipLaunchCooperativeKernel((void*)mega_fwd, dim3(grid_blocks), dim3(NTHR), args, LDS_BYTES, stream);
    if (e != hipSuccess) fprintf(stderr, "cooperative launch failed: %s (grid %d)\n", hipGetErrorString(e), grid_blocks);
}
```

```cpp
#include <hip/hip_runtime.h>
#include <hip/hip_cooperative_groups.h>
#include <cstdio>
#include <cstdint>
namespace cg = cooperative_groups;

typedef unsigned short bf16_t;
typedef short bf16x8 __attribute__((ext_vector_type(8)));
typedef float f32x4 __attribute__((ext_vector_type(4)));
typedef float f32x2 __attribute__((ext_vector_type(2)));
typedef unsigned u32x4 __attribute__((ext_vector_type(4)));
typedef unsigned u32x2 __attribute__((ext_vector_type(2)));
#define DI __device__ __forceinline__

constexpr int T_TOK = 32768, DM = 1024;
constexpr int NTHR = 512;
constexpr size_t OFF_XB0 = 0;
constexpr size_t OFF_XB1 = OFF_XB0 + (size_t)T_TOK * DM * 2;
constexpr size_t OFF_X1 = OFF_XB1 + (size_t)T_TOK * DM * 2;
constexpr size_t OFF_Y = OFF_X1 + (size_t)T_TOK * DM * 4;
constexpr size_t OFF_PRE = OFF_Y + (size_t)T_TOK * DM * 2;
constexpr size_t OFF_XBB = OFF_PRE;
constexpr size_t OFF_YS = OFF_PRE + (size_t)T_TOK * 256 * 2;
constexpr size_t OFF_SG = OFF_PRE + (size_t)T_TOK * 256 * 4;
constexpr size_t OFF_HL = OFF_SG + (size_t)T_TOK * 256 * 2;
constexpr size_t OFF_MEMB = OFF_HL + (size_t)256 * 1024 * 2 * 4;
constexpr size_t OFF_WIN = OFF_MEMB + (size_t)4096 * 1024 * 2;
constexpr size_t OFF_WOUT = OFF_WIN + (size_t)2 * 2560 * 1024 * 2;
constexpr size_t OFF_WGLU = OFF_WOUT + (size_t)2 * 1024 * 1024 * 2;
constexpr size_t OFF_WKV = OFF_WGLU + (size_t)2 * 256 * 256 * 2;
constexpr size_t OFF_WSP = OFF_WKV + (size_t)2 * 512 * 1024 * 2;
constexpr size_t OFF_S5T = OFF_WSP + (size_t)2 * 4 * 128 * 128 * 2;
constexpr size_t OFF_L8 = OFF_S5T + (size_t)32 * 3 * 128 * 128 * 2;
constexpr size_t OFF_L128 = OFF_L8 + (size_t)32 * 64 * 2 * 4;
constexpr size_t OFF_KB = OFF_L128 + (size_t)32 * 64 * 2 * 4;
constexpr size_t OFF_VP = OFF_KB + (size_t)2 * 4096 * 256 * 2;
constexpr size_t OFF_GX = OFF_VP + (size_t)2 * 4096 * 256 * 2;
constexpr size_t WS_TOTAL = OFF_GX + (size_t)T_TOK * 256 * 2;

constexpr int LDS_BYTES = 147456;
constexpr float LN_EPS = 1e-5f;
constexpr float DN_ALPHA = 1.41421356237f;

struct Params {
    const float *x, *mem, *w_in, *gm_w_s, *gm_b_s, *gm_ln_g, *gm_ln_b, *lam_re, *lam_im, *log_step, *b_re, *b_im, *c_re, *c_im, *ssm_d, *glu_w, *glu_b, *w_k,
        *w_v, *w_out, *ln_g, *ln_b;
    float* out;
    char* ws;
};

typedef __bf16 bf16x2_t __attribute__((ext_vector_type(2)));
DI unsigned pk2(float lo, float hi) { const f32x2 v = {lo, hi}; const bf16x2_t b = __builtin_convertvector(v, bf16x2_t); return __builtin_bit_cast(unsigned, b); }
DI unsigned bf16_bits(float x) { return pk2(x, 0.f) & 0xffffu; }
DI float bf2f(unsigned b) { return __uint_as_float(b << 16); }
DI float sigmoid_f(float x) { return __builtin_amdgcn_rcpf(1.f + __builtin_amdgcn_exp2f(x * -1.44269504089f)); }
DI float silu_f(float x) { return x * sigmoid_f(x); }
DI float gelu_f(float x) {
    const float t = x * (-2.30220819f + -0.102943240f * (x * x));
    return x * __builtin_amdgcn_rcpf(1.f + __builtin_amdgcn_exp2f(t));
}
DI int opaque_tid() { int t = threadIdx.x; asm volatile("" : "+v"(t)); return t; }
DI f32x4 mfma16(bf16x8 a, bf16x8 b, f32x4 c) { return __builtin_amdgcn_mfma_f32_16x16x32_bf16(a, b, c, 0, 0, 0); }

template <int N> DI void wait_vm() { asm volatile("s_waitcnt vmcnt(%0)" ::"n"(N) : "memory"); }
DI void raw_barrier() { asm volatile("" ::: "memory"); __builtin_amdgcn_s_barrier(); asm volatile("" ::: "memory"); }

template <int BM, int BN, int WR, int WC, int NSEG, bool SWAP, int NST, int DBG = 0>
DI void gemm_main(const bf16_t* __restrict__ A, const bf16_t* __restrict__ Bt, const int ldbk, char* lds, f32x4 (&acc)[BM / WR / 16][BN / WC / 16]) {
    constexpr int WM = BM / WR, WN = BN / WC, MT = WM / 16, NT = WN / 16, ROWS = BM + BN, NCH = ROWS * 4, NIT = (NCH + 511) / 512, BUF = ROWS * 64, KT = 32;
    constexpr int NTS = NT / NSEG, D = NST - 1;
    static_assert(D == 1 || (NCH % 512 == 0), "deep ring needs a uniform per-thread load count");
    const int tid = opaque_tid(), lane = tid & 63, wid = tid >> 6, wr = wid / WC, wc = wid % WC, l15 = lane & 15, quad = lane >> 4;
    const int lrow = tid >> 2, lc = tid & 3;
    const int lcg = lc ^ ((0 - (tid >> 4)) & 3);
    const int rsw = (quad ^ ((0 - (l15 >> 2)) & 3)) << 4;
#pragma unroll
    for (int mt = 0; mt < MT; ++mt)
#pragma unroll
        for (int nt = 0; nt < NT; ++nt) acc[mt][nt] = (f32x4){0.f, 0.f, 0.f, 0.f};
    const unsigned loff = (unsigned)(lrow * 64 + lcg * 16);
    const int koff = (int)((blockIdx.x >> 3) + (blockIdx.x & 7) * 4) & (KT - 1);
    auto issue_one = [&](int kt, int b, int i) {
        const int row = lrow + 128 * i;
        if ((NCH % 512 == 0) || (i < NCH / 512) || row < ROWS) {
            const int kq = (kt + koff) & (KT - 1);
            const char* ua = (const char*)A + (size_t)((DBG & 1) ? 0 : kq) * (BM * 64);
            const char* ub = (const char*)Bt + (size_t)((DBG & 2) ? 0 : kq) * ((size_t)ldbk * 2);
            const char* src;
            if (BM % 128 == 0) src = (i < BM / 128) ? (ua + i * 8192 + loff) : (ub + (i * 128 - BM) * 64 + loff);
            else if (i == 0) src = (lrow < BM) ? (ua + loff) : (ub + loff - BM * 64);
            else src = ub + (i * 128 - BM) * 64 + loff;
            __builtin_amdgcn_global_load_lds((const unsigned*)src, (unsigned*)(lds + b * BUF + i * 8192 + tid * 16), 16, 0, 0);
        }
    };
    auto issue = [&](int kt, int b) {
#pragma unroll
        for (int i = 0; i < NIT; ++i) issue_one(kt, b, i);
    };
    auto compute = [&](int cb, bool do_issue, int ikt, int ib) {
        const char* base = lds + cb * BUF;
        bf16x8 af[MT], bfr[NT];
#pragma unroll
        for (int nt = 0; nt < NT; ++nt) {
            const int br = BM + (nt / NTS) * (BN / NSEG) + wc * (NTS * 16) + (nt % NTS) * 16;
            bfr[nt] = *(const bf16x8*)(base + (br + l15) * 64 + rsw);
        }
#pragma unroll
        for (int mt = 0; mt < MT; ++mt) af[mt] = *(const bf16x8*)(base + (wr * WM + mt * 16 + l15) * 64 + rsw);
        constexpr int TOT = MT * NT, PER = (TOT + NIT - 1) / NIT;
#pragma unroll
        for (int part = 0; part < NIT; ++part) {
#pragma unroll
            for (int q = 0; q < PER; ++q) {
                const int idx = part * PER + q;
                if (idx < TOT) {
                    const int mt = idx / NT, nt = idx % NT;
                    acc[mt][nt] = SWAP ? mfma16(bfr[nt], af[mt], acc[mt][nt]) : mfma16(af[mt], bfr[nt], acc[mt][nt]);
                }
            }
            __builtin_amdgcn_sched_barrier(0);
            if (do_issue) issue_one(ikt, ib, part);
            __builtin_amdgcn_sched_barrier(0);
        }
    };
    __syncthreads();
#pragma unroll
    for (int d = 0; d < D; ++d) issue(d, d);
    int cb = 0, ib = D;
    for (int kt = 0; kt < KT; ++kt) {
        if (D > 1 && kt + D - 1 < KT) wait_vm<(D - 1) * NIT>(); else wait_vm<0>();
        raw_barrier();
        compute(cb, kt + D < KT, kt + D, ib);
        cb = (cb + 1 == NST) ? 0 : cb + 1;
        ib = (ib + 1 == NST) ? 0 : ib + 1;
    }
    __syncthreads();
}

DI size_t y_off(int tok, int col) { return ((size_t)(((tok >> 6) * 32 + (col >> 5)) * 64 + (tok & 63))) * 32 + (col & 31); }
DI size_t xb_off(int tok, int col) { return ((size_t)(((tok >> 7) * 32 + (col >> 5)) * 128 + (tok & 127))) * 32 + (col & 31); }
#define WS_PTR(T, off) ((T*)(p.ws + (off)))

DI void transpose_tile(const float* __restrict__ src, int ldsrc, bf16_t* __restrict__ dst, int ntot, int n0, int k0, float* tile) {
    const int tid = threadIdx.x, c = tid & 63, r0 = tid >> 6;
#pragma unroll
    for (int i = 0; i < 8; ++i) { const int r = r0 + 8 * i; tile[r * 65 + c] = src[(size_t)r * ldsrc + c]; }
    __syncthreads();
#pragma unroll
    for (int i = 0; i < 8; ++i) {
        const int rr = r0 + 8 * i, k = k0 + c;
        dst[((size_t)(k >> 5) * ntot + n0 + rr) * 32 + (k & 31)] = (bf16_t)bf16_bits(tile[c * 65 + rr]);
    }
    __syncthreads();
}

DI void transpose_glu(const float* __restrict__ src, bf16_t* __restrict__ dst, float* tile) {
    const int tid = threadIdx.x, c = tid & 63, r0 = tid >> 6;
#pragma unroll
    for (int i = 0; i < 8; ++i) { const int r = r0 + 8 * i; tile[r * 65 + c] = src[(size_t)r * 256 + c]; }
    __syncthreads();
#pragma unroll
    for (int i = 0; i < 8; ++i) { const int rr = r0 + 8 * i; dst[(size_t)rr * 256 + c] = (bf16_t)bf16_bits(tile[c * 65 + rr]); }
    __syncthreads();
}

DI void s5_tables(const Params& p, char* lds, int lg) {
    const int tid = threadIdx.x;
    float* Lr = (float*)lds;
    float* Li = Lr + 9 * 64;
    float* Wr = Li + 9 * 64;
    float* Wi = Wr + 64;
    float* Bbr = Wi + 64;
    float* Bbi = Bbr + 1024;
    float* Cr = Bbi + 1024;
    float* Ci = Cr + 1024;
    float* Kt = Ci + 1024;
    __syncthreads();
    if (tid < 64) {
        const int pp = tid;
        const float dt = __expf(p.log_step[lg]);
        const float lr = p.lam_re[lg * 64 + pp], li = p.lam_im[lg * 64 + pp];
        const float a = lr * dt, b = li * dt;
        const float ea = expf(a);
        float sb, cb;
        sincosf(b, &sb, &cb);
        const float Lre = ea * cb, Lim = ea * sb;
        const float sh = sinf(0.5f * b);
        const float m1r = expm1f(a) * cb - 2.f * sh * sh, m1i = ea * sb;
        const float inv = 1.f / (lr * lr + li * li);
        Wr[pp] = (m1r * lr + m1i * li) * inv;
        Wi[pp] = (m1i * lr - m1r * li) * inv;
        float pr = 1.f, pi = 0.f;
#pragma unroll
        for (int t = 0; t < 9; ++t) {
            Lr[t * 64 + pp] = pr; Li[t * 64 + pp] = pi;
            const float nr = pr * Lre - pi * Lim, ni = pr * Lim + pi * Lre;
            pr = nr; pi = ni;
        }
        float qr = Lr[8 * 64 + pp], qi = Li[8 * 64 + pp];
        f32x2* L8 = WS_PTR(f32x2, OFF_L8);
        L8[lg * 64 + pp] = (f32x2){qr, qi};
#pragma unroll
        for (int s = 0; s < 4; ++s) { const float nr = qr * qr - qi * qi, ni = 2.f * qr * qi; qr = nr; qi = ni; }
        f32x2* L128 = WS_PTR(f32x2, OFF_L128);
        L128[lg * 64 + pp] = (f32x2){qr, qi};
    }
    __syncthreads();
    for (int e = tid; e < 1024; e += NTHR) {
        const int pp = e >> 4;
        const float br = p.b_re[lg * 1024 + e], bi = p.b_im[lg * 1024 + e];
        Bbr[e] = Wr[pp] * br - Wi[pp] * bi;
        Bbi[e] = Wr[pp] * bi + Wi[pp] * br;
        Cr[e] = p.c_re[lg * 1024 + e];
        Ci[e] = p.c_im[lg * 1024 + e];
    }
    __syncthreads();
    for (int e = tid; e < 2048; e += NTHR) {
        const int tau = e >> 8, c = (e >> 4) & 15, c2 = e & 15;
        float s = 0.f;
        for (int pp = 0; pp < 64; ++pp) {
            const float cr = Cr[c * 64 + pp], ci = Ci[c * 64 + pp], lr = Lr[tau * 64 + pp], li = Li[tau * 64 + pp];
            const float tr = cr * lr - ci * li, ti = cr * li + ci * lr;
            s += tr * Bbr[pp * 16 + c2] - ti * Bbi[pp * 16 + c2];
        }
        Kt[e] = s;
    }
    __syncthreads();
    bf16_t* T = WS_PTR(bf16_t, OFF_S5T) + (size_t)lg * 3 * 16384;
    for (int e = tid; e < 16384; e += NTHR) {
        const int n = e >> 7, k = e & 127;
        {
            const int tlo = n >> 4, c = n & 15, tli = k >> 4, c2 = k & 15;
            const float v = (tli <= tlo) ? Kt[((tlo - tli) * 16 + c) * 16 + c2] : 0.f;
            T[e] = (bf16_t)bf16_bits(v);
        }
        {
            const int pp = n & 63, ri = n >> 6, tli = k >> 4, c2 = k & 15;
            const float lr = Lr[(7 - tli) * 64 + pp], li = Li[(7 - tli) * 64 + pp], br = Bbr[pp * 16 + c2], bi = Bbi[pp * 16 + c2];
            const float v = ri ? (lr * bi + li * br) : (lr * br - li * bi);
            T[16384 + e] = (bf16_t)bf16_bits(v);
        }
        {
            const int tlo = n >> 4, c = n & 15, pp = k & 63, ri = k >> 6;
            const float lr = Lr[(tlo + 1) * 64 + pp], li = Li[(tlo + 1) * 64 + pp], cr = Cr[c * 64 + pp], ci = Ci[c * 64 + pp];
            const float v = ri ? -(cr * li + ci * lr) : (cr * lr - ci * li);
            T[32768 + e] = (bf16_t)bf16_bits(v);
        }
    }
    __syncthreads();
}

DI void prep_phase(const Params& p, char* lds) {
    const int tid = opaque_tid(), nb = gridDim.x, bid = blockIdx.x;
    for (int j = bid; j < 32; j += nb) s5_tables(p, lds, j);
    {
        float* tile = (float*)lds;
        for (int T = bid; T < 2080; T += nb) {
            const int l = T / 1040; int r = T % 1040;
            if (r < 640) {
                const int nt = r >> 4, kt = r & 15, n0 = nt * 64;
                int sc = n0;
                if (n0 < 1536) { const int h = n0 / 384, rem = n0 % 384, seg = rem >> 7, d0 = rem & 127; sc = seg * 512 + h * 128 + d0; }
                transpose_tile(p.w_in + (size_t)l * 1024 * 2560 + (size_t)(kt * 64) * 2560 + sc, 2560, WS_PTR(bf16_t, OFF_WIN) + (size_t)l * 2560 * 1024, 2560, n0, kt * 64, tile);
            } else if (r < 896) {
                r -= 640; const int nt = r >> 4, kt = r & 15;
                transpose_tile(p.w_out + (size_t)l * 1024 * 1024 + (size_t)(kt * 64) * 1024 + nt * 64, 1024, WS_PTR(bf16_t, OFF_WOUT) + (size_t)l * 1024 * 1024, 1024, nt * 64, kt * 64, tile);
            } else if (r < 912) {
                r -= 896; const int nt = r >> 2, kt = r & 3;
                transpose_glu(p.glu_w + (size_t)l * 65536 + (size_t)(kt * 64) * 256 + nt * 64, WS_PTR(bf16_t, OFF_WGLU) + (size_t)l * 65536 + (size_t)(nt * 64) * 256 + kt * 64, tile);
            } else if (r < 976) {
                r -= 912; const int nt = r >> 4, kt = r & 15;
                transpose_tile(p.w_k + (size_t)l * 262144 + (size_t)(kt * 64) * 256 + nt * 64, 256, WS_PTR(bf16_t, OFF_WKV) + (size_t)l * 524288, 512, nt * 64, kt * 64, tile);
            } else {
                r -= 976; const int nt = r >> 4, kt = r & 15;
                transpose_tile(p.w_v + (size_t)l * 262144 + (size_t)(kt * 64) * 256 + nt * 64, 256, WS_PTR(bf16_t, OFF_WKV) + (size_t)l * 524288, 512, 256 + nt * 64, kt * 64, tile);
            }
        }
    }
    {
        bf16_t* W = WS_PTR(bf16_t, OFF_WSP);
        for (int e = bid * NTHR + tid; e < 2 * 4 * 128 * 128; e += nb * NTHR) {
            const int s = e & 127, t = (e >> 7) & 127;
            W[e] = (s <= t) ? (bf16_t)bf16_bits(p.gm_w_s[e]) : (bf16_t)0;
        }
    }
    {
        auto conv = [&](const float* __restrict__ srcp, bf16_t* __restrict__ dstp, size_t n8) {
            for (size_t I = (size_t)bid * NTHR + tid; I < n8; I += (size_t)nb * NTHR) {
                const int c8 = (int)(I & 3), row = (int)(I >> 2) & 127, kt = (int)(I >> 9) & 31, blk = (int)(I >> 14);
                const float* s = srcp + ((size_t)(blk * 128 + row)) * 1024 + kt * 32 + c8 * 8;
                const f32x4 a = *(const f32x4*)s, b = *(const f32x4*)(s + 4);
                *(u32x4*)(dstp + I * 8) = (u32x4){pk2(a[0], a[1]), pk2(a[2], a[3]), pk2(b[0], b[1]), pk2(b[2], b[3])};
            }
        };
        conv(p.x, WS_PTR(bf16_t, OFF_XB0), (size_t)T_TOK * DM / 8);
        conv(p.mem, WS_PTR(bf16_t, OFF_MEMB), (size_t)4096 * DM / 8);
    }
}

DI void signal_done(unsigned* c) {
    wait_vm<0>();
    __syncthreads();
    if (threadIdx.x == 0) { __builtin_amdgcn_fence(__ATOMIC_RELEASE, "agent"); __hip_atomic_fetch_add(c, 1u, __ATOMIC_RELAXED, __HIP_MEMORY_SCOPE_AGENT); }
}
DI void wait_count(unsigned* c, unsigned need) {
    if (threadIdx.x == 0) {
        while (__hip_atomic_load(c, __ATOMIC_RELAXED, __HIP_MEMORY_SCOPE_AGENT) < need) __builtin_amdgcn_s_sleep(1);
        __builtin_amdgcn_fence(__ATOMIC_ACQUIRE, "agent");
    }
    __syncthreads();
}

DI void unit_KV(const Params& p, char* lds, int l, int mtile, int q) {
    const int tid = opaque_tid(), lane = tid & 63, wid = tid >> 6, wr = wid >> 2, wc = wid & 3, l15 = lane & 15, quad = lane >> 4;
    f32x4 acc[4][2];
    gemm_main<128, 128, 2, 4, 1, true, 3>(WS_PTR(const bf16_t, OFF_MEMB) + (size_t)mtile * 128 * 1024, WS_PTR(const bf16_t, OFF_WKV) + (size_t)l * 524288 + (size_t)(128 * q) * 32, 512 * 32, lds, acc);
    bf16_t* Kb = WS_PTR(bf16_t, OFF_KB) + (size_t)l * 4096 * 256;
    bf16_t* Vp = WS_PTR(bf16_t, OFF_VP) + (size_t)l * 4096 * 256;
#pragma unroll
    for (int mt = 0; mt < 4; ++mt) {
        const int r = mtile * 128 + wr * 64 + mt * 16 + l15, b = r >> 8, m = r & 255;
#pragma unroll
        for (int nt = 0; nt < 2; ++nt) {
            const int col = 128 * q + wc * 32 + nt * 16 + quad * 4;
            const f32x4 v = acc[mt][nt];
            if (q < 2) {
                const int head = col >> 6, d = col & 63;
                *(u32x2*)(Kb + ((size_t)((b * 4 + head) * 256 + m)) * 64 + d) = (u32x2){pk2(v[0], v[1]), pk2(v[2], v[3])};
            } else {
                const int cv = col - 256, head = cv >> 6, d = cv & 63;
                const int rr = m & 31, pos = (m & ~31) + 8 * ((rr >> 2) & 3) + 4 * (rr >> 4) + (rr & 3);
#pragma unroll
                for (int i = 0; i < 4; ++i) Vp[((size_t)((b * 4 + head) * 64 + d + i)) * 256 + pos] = (bf16_t)bf16_bits(v[i]);
            }
        }
    }
    signal_done(WS_PTR(unsigned, OFF_HL) + 64 + l * 16 + (mtile >> 1));
}

template <int CTRL> DI float dpp_f(float v) { return __builtin_bit_cast(float, __builtin_amdgcn_update_dpp(0, __builtin_bit_cast(int, v), CTRL, 0xF, 0xF, true)); }
DI float row16_sum(float v) {
    v += dpp_f<0xB1>(v);
    v += dpp_f<0x4E>(v);
    v += dpp_f<0x141>(v);
    v += dpp_f<0x140>(v);
    return v;
}

DI void unit_A(const Params& p, char* lds, int l, int chunk, int h) {
    const int tid = opaque_tid(), lane = tid & 63, wid = tid >> 6, wr = wid >> 2, wc = wid & 3, l15 = lane & 15, quad = lane >> 4;
    f32x4 acc[4][6];
    const bf16_t* xb = WS_PTR(const bf16_t, l == 0 ? OFF_XB0 : OFF_XB1);
    char* WL = lds + 98304;
    __syncthreads();
    {
        const bf16_t* W = WS_PTR(const bf16_t, OFF_WSP) + (size_t)(l * 4 + h) * 16384;
#pragma unroll
        for (int i = 0; i < 4; ++i) {
            const int piece = wid + 8 * i, row = piece * 4 + (lane >> 4), lc = (lane & 15) ^ (row & 15);
            __builtin_amdgcn_global_load_lds((const unsigned*)(W + row * 128 + lc * 8), (unsigned*)(WL + piece * 1024 + lane * 16), 16, 0, 0);
        }
    }
    gemm_main<128, 384, 2, 4, 3, false, 3>(xb + (size_t)chunk * 128 * 1024, WS_PTR(const bf16_t, OFF_WIN) + (size_t)l * 2560 * 1024 + (size_t)h * 384 * 32, 2560 * 32, lds, acc);
    float* stat = (float*)lds;
    char* Vt = lds + 4096;
    float lgv[2], lbv[2];
#pragma unroll
    for (int n2 = 0; n2 < 2; ++n2) { const int d = wc * 32 + n2 * 16 + l15; lgv[n2] = p.gm_ln_g[(l * 4 + h) * 128 + d]; lbv[n2] = p.gm_ln_b[(l * 4 + h) * 128 + d]; }
    f32x4 bsv[4];
#pragma unroll
    for (int mt = 0; mt < 4; ++mt) bsv[mt] = *(const f32x4*)(p.gm_b_s + (l * 4 + h) * 128 + wr * 64 + mt * 16 + quad * 4);
    {
        float sv[4][4], ssv[4][4];
#pragma unroll
        for (int mt = 0; mt < 4; ++mt)
#pragma unroll
            for (int i = 0; i < 4; ++i) {
                float s = 0.f, ss = 0.f;
#pragma unroll
                for (int n2 = 0; n2 < 2; ++n2) { const float v = gelu_f(acc[mt][2 + n2][i]); acc[mt][2 + n2][i] = v; s += v; ss += v * v; }
                sv[mt][i] = s; ssv[mt][i] = ss;
            }
#pragma unroll
        for (int mt = 0; mt < 4; ++mt)
#pragma unroll
            for (int i = 0; i < 4; ++i) { sv[mt][i] = row16_sum(sv[mt][i]); ssv[mt][i] = row16_sum(ssv[mt][i]); }
        if (l15 == 0) {
#pragma unroll
            for (int mt = 0; mt < 4; ++mt)
#pragma unroll
                for (int i = 0; i < 4; ++i) { const int row = wr * 64 + mt * 16 + quad * 4 + i; *(f32x2*)&stat[(row * 4 + wc) * 2] = (f32x2){sv[mt][i], ssv[mt][i]}; }
        }
    }
    __syncthreads();
#pragma unroll
    for (int mt = 0; mt < 4; ++mt) {
        float mu[4], rs[4];
#pragma unroll
        for (int i = 0; i < 4; ++i) {
            const int row = wr * 64 + mt * 16 + quad * 4 + i;
            const f32x4 a = *(const f32x4*)&stat[row * 8], b = *(const f32x4*)&stat[row * 8 + 4];
            const float s = (a[0] + a[2]) + (b[0] + b[2]), ss = (a[1] + a[3]) + (b[1] + b[3]);
            mu[i] = s * (1.f / 128.f);
            const float var = ss * (1.f / 128.f) - mu[i] * mu[i];
            rs[i] = rsqrtf(var + LN_EPS);
        }
#pragma unroll
        for (int n2 = 0; n2 < 2; ++n2) {
            const int d = wc * 32 + n2 * 16 + l15;
            float v[4];
#pragma unroll
            for (int i = 0; i < 4; ++i) v[i] = (acc[mt][2 + n2][i] - mu[i]) * rs[i] * lgv[n2] + lbv[n2];
            *(u32x2*)(Vt + d * 272 + (wr * 64 + mt * 16 + quad * 4) * 2) = (u32x2){pk2(v[0], v[1]), pk2(v[2], v[3])};
        }
    }
    __syncthreads();
    f32x4 mx[4][2];
#pragma unroll
    for (int mt = 0; mt < 4; ++mt) { mx[mt][0] = (f32x4){0.f, 0.f, 0.f, 0.f}; mx[mt][1] = (f32x4){0.f, 0.f, 0.f, 0.f}; }
#pragma unroll
    for (int ks = 0; ks < 4; ++ks) {
        if (32 * ks <= 64 * wr + 63) {
            bf16x8 bv[2];
#pragma unroll
            for (int n2 = 0; n2 < 2; ++n2) bv[n2] = *(const bf16x8*)(Vt + (wc * 32 + n2 * 16 + l15) * 272 + (32 * ks + 8 * quad) * 2);
#pragma unroll
            for (int mt = 0; mt < 4; ++mt) {
                if (32 * ks <= 64 * wr + 16 * mt + 15) {
                    const bf16x8 aw = *(const bf16x8*)(WL + (wr * 64 + mt * 16 + l15) * 256 + (((4 * ks + quad) ^ l15) << 4));
                    mx[mt][0] = mfma16(aw, bv[0], mx[mt][0]);
                    mx[mt][1] = mfma16(aw, bv[1], mx[mt][1]);
                }
            }
        }
    }
    bf16_t* yo = WS_PTR(bf16_t, OFF_Y) + ((size_t)((chunk * 2 + wr) * 32 + 4 * h + wc) * 64 + quad * 4) * 32 + l15;
#pragma unroll
    for (int mt = 0; mt < 4; ++mt)
#pragma unroll
        for (int i = 0; i < 4; ++i) {
            const float b = bsv[mt][i];
#pragma unroll
            for (int n2 = 0; n2 < 2; ++n2) {
                const float val = gelu_f(acc[mt][n2][i]) * (mx[mt][n2][i] + b) * silu_f(acc[mt][4 + n2][i]);
                yo[(mt * 16 + i) * 32 + n2 * 16] = (bf16_t)bf16_bits(val);
            }
        }
}

#ifndef PROBE_DBG
#define PROBE_DBG -1
#endif
template <int DBG>
DI void unit_A_dummy(const Params& p, char* lds, int l, int chunk, int h) {
    f32x4 acc[4][6];
    const bf16_t* xb = WS_PTR(const bf16_t, l == 0 ? OFF_XB0 : OFF_XB1);
    gemm_main<128, 384, 2, 4, 3, false, 3, DBG>(xb + (size_t)chunk * 128 * 1024, WS_PTR(const bf16_t, OFF_WIN) + (size_t)l * 2560 * 1024 + (size_t)h * 384 * 32, 2560 * 32, lds, acc);
    float s = 0.f;
#pragma unroll
    for (int mt = 0; mt < 4; ++mt)
#pragma unroll
        for (int nt = 0; nt < 6; ++nt) s += acc[mt][nt][0] + acc[mt][nt][1] + acc[mt][nt][2] + acc[mt][nt][3];
    if (s == 123456.789f) WS_PTR(float, OFF_HL)[0] = s;
}

DI void unit_B1(const Params& p, char* lds, int l, int chunk) {
    const int tid = opaque_tid(), lane = tid & 63, wid = tid >> 6, wr = wid >> 2, wc = wid & 3, l15 = lane & 15, quad = lane >> 4;
    const bf16_t* xb = WS_PTR(const bf16_t, l == 0 ? OFF_XB0 : OFF_XB1);
    f32x4 acc[4][8];
    gemm_main<128, 512, 2, 4, 1, true, 3>(xb + (size_t)chunk * 128 * 1024, WS_PTR(const bf16_t, OFF_WIN) + (size_t)l * 2560 * 1024 + (size_t)1536 * 32, 2560 * 32, lds, acc);
    bf16_t* sgd = WS_PTR(bf16_t, OFF_SG) + (size_t)chunk * 128 * 256;
    bf16_t* xbd = WS_PTR(bf16_t, OFF_XBB) + (size_t)(chunk >> 4) * 16 * 2048 * 16;
#pragma unroll
    for (int mt = 0; mt < 4; ++mt) {
        const int tok = wr * 64 + mt * 16 + l15;
#pragma unroll
        for (int nt = 0; nt < 8; ++nt) {
            f32x4 v = acc[mt][nt];
            if (wc >= 2) {
                v[0] = silu_f(v[0]); v[1] = silu_f(v[1]); v[2] = silu_f(v[2]); v[3] = silu_f(v[3]);
                const int col = (wc & 1) * 128 + nt * 16 + quad * 4;
                *(u32x2*)(sgd + (size_t)tok * 256 + col) = (u32x2){pk2(v[0], v[1]), pk2(v[2], v[3])};
            } else {
                const int g = (wc & 1) * 8 + nt, tb = (chunk & 15) * 128 + tok;
                *(u32x2*)(xbd + ((size_t)g * 2048 + tb) * 16 + quad * 4) = (u32x2){pk2(v[0], v[1]), pk2(v[2], v[3])};
            }
        }
    }
    signal_done(WS_PTR(unsigned, OFF_HL) + 128 + l * 16 + (chunk >> 4));
}

DI void unit_S5(const Params& p, char* lds, int l, int b, int g) {
    const int tid = opaque_tid(), lane = tid & 63, wid = tid >> 6, l15 = lane & 15, quad = lane >> 4;
    const int lg = l * 16 + g;
    const bf16_t* T = WS_PTR(const bf16_t, OFF_S5T) + (size_t)lg * 3 * 16384;
    float* HLb = (float*)lds;
    float* EndS = (float*)(lds + 67584);
    bf16x8 wst[4], wintra[4], wcar[4];
#pragma unroll
    for (int ks = 0; ks < 4; ++ks) {
        wintra[ks] = *(const bf16x8*)(T + (16 * wid + l15) * 128 + 32 * ks + 8 * quad);
        wst[ks] = *(const bf16x8*)(T + 16384 + (16 * wid + l15) * 128 + 32 * ks + 8 * quad);
        wcar[ks] = *(const bf16x8*)(T + 32768 + (16 * wid + l15) * 128 + 32 * ks + 8 * quad);
    }
    const f32x2 L8 = WS_PTR(const f32x2, OFF_L8)[lg * 64 + lane], L128 = WS_PTR(const f32x2, OFF_L128)[lg * 64 + lane];
    const bf16_t* Xg = WS_PTR(const bf16_t, OFF_XBB) + ((size_t)(b * 16 + g) * 2048) * 16;
    bf16_t* YSo = WS_PTR(bf16_t, OFF_YS) + (size_t)b * 2048 * 256 + 16 * g;
    const float dsk = p.ssm_d[l * 256 + 16 * g + l15];
    char* Xl = lds + 75776;
    __syncthreads();
    wait_count(WS_PTR(unsigned, OFF_HL) + 128 + l * 16 + b, 16u);
#pragma unroll
    for (int i = 0; i < 8; ++i) {
        const int P = (wid * 8 + i) * 64 + lane, S = P ^ ((P >> 4) & 15);
        __builtin_amdgcn_global_load_lds((const unsigned*)(Xg + (size_t)S * 8), (unsigned*)(Xl + P * 16), 16, 0, 0);
    }
    wait_vm<0>();
    __syncthreads();
    auto xfrag = [&](int c, int ks) -> bf16x8 {
        const int tok = 128 * c + 8 * l15 + 2 * ks + (quad >> 1), S = tok * 2 + (quad & 1);
        return *(const bf16x8*)(Xl + ((S ^ ((S >> 4) & 15)) << 4));
    };
    for (int half = 0; half < 2; ++half) {
#pragma unroll 2
        for (int cl = 0; cl < 8; ++cl) {
            const int c = half * 8 + cl;
            f32x4 hl = (f32x4){0.f, 0.f, 0.f, 0.f};
#pragma unroll
            for (int ks = 0; ks < 4; ++ks) {
                const bf16x8 xa = xfrag(c, ks);
                hl = mfma16(xa, wst[ks], hl);
            }
#pragma unroll
            for (int i = 0; i < 4; ++i) HLb[cl * 2112 + (4 * quad + i) * 132 + 16 * wid + l15] = hl[i];
        }
        __syncthreads();
        {
            float* H = HLb + wid * 2112;
            float ar[16], ai[16];
#pragma unroll
            for (int j = 0; j < 16; ++j) { ar[j] = H[j * 132 + lane]; ai[j] = H[j * 132 + 64 + lane]; }
            float hr = 0.f, hi = 0.f;
#pragma unroll
            for (int j = 0; j < 16; ++j) {
                const float pr = hr, pi = hi;
                const float nr = L8.x * hr - L8.y * hi + ar[j], ni = L8.x * hi + L8.y * hr + ai[j];
                hr = nr; hi = ni;
                H[j * 132 + lane] = pr; H[j * 132 + 64 + lane] = pi;
            }
            EndS[(half * 8 + wid) * 128 + lane] = hr;
            EndS[(half * 8 + wid) * 128 + 64 + lane] = hi;
        }
        __syncthreads();
        {
            const int c = half * 8 + wid;
            float er[15], ei[15];
#pragma unroll
            for (int cc = 0; cc < 15; ++cc) { er[cc] = (cc < c) ? EndS[cc * 128 + lane] : 0.f; ei[cc] = (cc < c) ? EndS[cc * 128 + 64 + lane] : 0.f; }
            float* H = HLb + wid * 2112;
            float fr[16], fi[16];
#pragma unroll
            for (int j = 0; j < 16; ++j) { fr[j] = H[j * 132 + lane]; fi[j] = H[j * 132 + 64 + lane]; }
            float hr = 0.f, hi = 0.f;
#pragma unroll
            for (int cc = 0; cc < 15; ++cc) {
                if (cc < c) { const float nr = L128.x * hr - L128.y * hi + er[cc], ni = L128.x * hi + L128.y * hr + ei[cc]; hr = nr; hi = ni; }
            }
            asm volatile("s_waitcnt lgkmcnt(0)" ::: "memory");
#pragma unroll
            for (int j = 0; j < 16; ++j) {
                bf16_t* hp = (bf16_t*)(H + j * 132);
                hp[lane] = (bf16_t)bf16_bits(fr[j] + hr);
                hp[64 + lane] = (bf16_t)bf16_bits(fi[j] + hi);
                const float nr = L8.x * hr - L8.y * hi, ni = L8.x * hi + L8.y * hr;
                hr = nr; hi = ni;
            }
        }
        __syncthreads();
#pragma unroll 2
        for (int cl = 0; cl < 8; ++cl) {
            const int c = half * 8 + cl;
            const char* H = (const char*)(HLb + cl * 2112);
            f32x4 y = (f32x4){0.f, 0.f, 0.f, 0.f};
#pragma unroll
            for (int ks = 0; ks < 4; ++ks) {
                const bf16x8 xa = xfrag(c, ks);
                y = mfma16(xa, wintra[ks], y);
            }
#pragma unroll
            for (int ks = 0; ks < 4; ++ks) {
                const bf16x8 hp = *(const bf16x8*)(H + l15 * 528 + (32 * ks + 8 * quad) * 2);
                y = mfma16(hp, wcar[ks], y);
            }
#pragma unroll
            for (int i = 0; i < 4; ++i) {
                const int tokl = 128 * c + 8 * (4 * quad + i) + wid;
                const int S = tokl * 2 + (l15 >> 3);
                const float xv = bf2f(*(const bf16_t*)(Xl + ((S ^ ((S >> 4) & 15)) << 4) + (l15 & 7) * 2));
                YSo[(size_t)tokl * 256 + l15] = (bf16_t)bf16_bits(gelu_f(y[i] + dsk * xv));
            }
        }
        __syncthreads();
    }
}

DI void glu_prologue(const Params& p, char* lds, int l, int tile) {
    const int tid = opaque_tid(), lane = tid & 63, wid = tid >> 6, l15 = lane & 15, quad = lane >> 4;
    char* Ys = lds;
    const bf16_t* ysg = WS_PTR(const bf16_t, OFF_YS) + (size_t)tile * 64 * 256;
    __syncthreads();
#pragma unroll
    for (int i = 0; i < 4; ++i) {
        const int idx = tid + NTHR * i, row = idx >> 5, c16 = idx & 31;
        *(u32x4*)(Ys + row * 528 + c16 * 16) = *(const u32x4*)(ysg + (size_t)row * 256 + c16 * 8);
    }
    __syncthreads();
    f32x4 acc[4][2];
#pragma unroll
    for (int mt = 0; mt < 4; ++mt) { acc[mt][0] = (f32x4){0.f, 0.f, 0.f, 0.f}; acc[mt][1] = (f32x4){0.f, 0.f, 0.f, 0.f}; }
    const bf16_t* Wg = WS_PTR(const bf16_t, OFF_WGLU) + (size_t)l * 65536;
#pragma unroll 2
    for (int ks = 0; ks < 8; ++ks) {
        bf16x8 a[4], bb[2];
#pragma unroll
        for (int mt = 0; mt < 4; ++mt) a[mt] = *(const bf16x8*)(Ys + (mt * 16 + l15) * 528 + (32 * ks + 8 * quad) * 2);
#pragma unroll
        for (int nt = 0; nt < 2; ++nt) bb[nt] = *(const bf16x8*)(Wg + (wid * 32 + nt * 16 + l15) * 256 + 32 * ks + 8 * quad);
#pragma unroll
        for (int mt = 0; mt < 4; ++mt)
#pragma unroll
            for (int nt = 0; nt < 2; ++nt) acc[mt][nt] = mfma16(bb[nt], a[mt], acc[mt][nt]);
    }
    const bf16_t* sg = WS_PTR(const bf16_t, OFF_SG) + (size_t)tile * 64 * 256;
    bf16_t* yo = WS_PTR(bf16_t, OFF_Y);
#pragma unroll
    for (int mt = 0; mt < 4; ++mt) {
        const int tok = mt * 16 + l15;
#pragma unroll
        for (int nt = 0; nt < 2; ++nt) {
            const int n0 = wid * 32 + nt * 16 + quad * 4;
            const f32x4 gb = *(const f32x4*)(p.glu_b + l * 256 + n0);
            const u32x2 yv = *(const u32x2*)(Ys + tok * 528 + n0 * 2);
            const u32x2 sv = *(const u32x2*)(sg + (size_t)tok * 256 + n0);
            float o[4];
            o[0] = sigmoid_f(acc[mt][nt][0] + gb[0]) * bf2f(yv[0] & 0xffffu) * bf2f(sv[0] & 0xffffu);
            o[1] = sigmoid_f(acc[mt][nt][1] + gb[1]) * bf2f(yv[0] >> 16) * bf2f(sv[0] >> 16);
            o[2] = sigmoid_f(acc[mt][nt][2] + gb[2]) * bf2f(yv[1] & 0xffffu) * bf2f(sv[1] & 0xffffu);
            o[3] = sigmoid_f(acc[mt][nt][3] + gb[3]) * bf2f(yv[1] >> 16) * bf2f(sv[1] >> 16);
            *(u32x2*)(yo + y_off(tile * 64 + tok, 512 + n0)) = (u32x2){pk2(o[0], o[1]), pk2(o[2], o[3])};
        }
    }
    wait_vm<0>();
}

DI void unit_X(const Params& p, char* lds, int l, int chunk) {
    const int tid = opaque_tid(), lane = tid & 63, wid = tid >> 6, wr = wid >> 2, wc = wid & 3, l15 = lane & 15, quad = lane >> 4;
    const bf16_t* xb = WS_PTR(const bf16_t, l == 0 ? OFF_XB0 : OFF_XB1);
    char* Qs = lds;
    bf16_t* gx = WS_PTR(bf16_t, OFF_GX) + (size_t)chunk * 128 * 256;
    {
        f32x4 acc[4][8];
        gemm_main<128, 512, 2, 4, 1, true, 3>(xb + (size_t)chunk * 128 * 1024, WS_PTR(const bf16_t, OFF_WIN) + (size_t)l * 2560 * 1024 + (size_t)2048 * 32, 2560 * 32, lds, acc);
#pragma unroll
        for (int mt = 0; mt < 4; ++mt) {
            const int tok = wr * 64 + mt * 16 + l15;
#pragma unroll
            for (int nt = 0; nt < 8; ++nt) {
                const f32x4 v = acc[mt][nt];
                if (wc < 2) {
                    const int col = wc * 128 + nt * 16 + quad * 4;
                    const float qs = 0.125f * 1.44269504089f;
                    *(u32x2*)(Qs + tok * 528 + col * 2) = (u32x2){pk2(v[0] * qs, v[1] * qs), pk2(v[2] * qs, v[3] * qs)};
                } else {
                    const int col = (wc - 2) * 128 + nt * 16 + quad * 4;
                    *(u32x2*)(gx + (size_t)tok * 256 + col) = (u32x2){pk2(silu_f(v[0]), silu_f(v[1])), pk2(silu_f(v[2]), silu_f(v[3]))};
                }
            }
        }
    }
    __syncthreads();
    bf16x8 bq[4][2];
#pragma unroll
    for (int h = 0; h < 4; ++h)
#pragma unroll
        for (int ks = 0; ks < 2; ++ks) bq[h][ks] = *(const bf16x8*)(Qs + (wid * 16 + l15) * 528 + (64 * h + 32 * ks + 8 * quad) * 2);
    const int b = chunk >> 4;
    if (l == 0) wait_count(WS_PTR(unsigned, OFF_HL) + 64 + l * 16 + b, 8u); else __syncthreads();
    const bf16_t* Kb = WS_PTR(const bf16_t, OFF_KB) + (size_t)l * 4096 * 256 + (size_t)(b * 4) * 256 * 64;
    const bf16_t* Vb = WS_PTR(const bf16_t, OFF_VP) + (size_t)l * 4096 * 256 + (size_t)(b * 4) * 64 * 256;
    bf16_t* yo = WS_PTR(bf16_t, OFF_Y);
    auto issue_kv = [&](int h, int buf) {
        const bf16_t* Kh = Kb + (size_t)h * 256 * 64;
        const bf16_t* Vh = Vb + (size_t)h * 64 * 256;
        char* kd = lds + buf * 65536;
        char* vd = kd + 32768;
#pragma unroll
        for (int i = 0; i < 4; ++i) {
            const int piece = wid + 8 * i;
            {
                const int row = piece * 8 + (lane >> 3), lc = (lane & 7) ^ ((row >> 1) & 7);
                __builtin_amdgcn_global_load_lds((const unsigned*)(Kh + row * 64 + lc * 8), (unsigned*)(kd + piece * 1024 + lane * 16), 16, 0, 0);
            }
            {
                const int row = piece * 2 + (lane >> 5), lc = (lane & 31) ^ (row & 15);
                __builtin_amdgcn_global_load_lds((const unsigned*)(Vh + row * 256 + lc * 8), (unsigned*)(vd + piece * 1024 + lane * 16), 16, 0, 0);
            }
        }
    };
    issue_kv(0, 0);
    const int tok = wid * 16 + l15;
#pragma unroll
    for (int h = 0; h < 4; ++h) {
        wait_vm<0>();
        raw_barrier();
        if (h < 3) issue_kv(h + 1, (h + 1) & 1);
        const char* kd = lds + (h & 1) * 65536;
        const char* vd = kd + 32768;
        f32x4 s[16];
#pragma unroll
        for (int mt = 0; mt < 16; ++mt) s[mt] = (f32x4){0.f, 0.f, 0.f, 0.f};
#pragma unroll
        for (int ks = 0; ks < 2; ++ks) {
#pragma unroll
            for (int mt = 0; mt < 16; ++mt) {
                const int row = 16 * mt + l15;
                const bf16x8 ak = *(const bf16x8*)(kd + row * 128 + (((4 * ks + quad) ^ ((row >> 1) & 7)) << 4));
                s[mt] = mfma16(ak, bq[h][ks], s[mt]);
            }
        }
        float mxv = -3.0e38f;
#pragma unroll
        for (int mt = 0; mt < 16; ++mt)
#pragma unroll
            for (int i = 0; i < 4; ++i) mxv = fmaxf(mxv, s[mt][i]);
        mxv = fmaxf(mxv, __shfl_xor(mxv, 16));
        mxv = fmaxf(mxv, __shfl_xor(mxv, 32));
        float sum = 0.f;
#pragma unroll
        for (int mt = 0; mt < 16; ++mt)
#pragma unroll
            for (int i = 0; i < 4; ++i) { const float e = __builtin_amdgcn_exp2f(s[mt][i] - mxv); s[mt][i] = e; sum += e; }
        sum += __shfl_xor(sum, 16);
        sum += __shfl_xor(sum, 32);
        const float inv = 1.f / sum;
        f32x4 o[4];
#pragma unroll
        for (int dt = 0; dt < 4; ++dt) o[dt] = (f32x4){0.f, 0.f, 0.f, 0.f};
#pragma unroll
        for (int ks = 0; ks < 8; ++ks) {
            const f32x4 a = s[2 * ks], c = s[2 * ks + 1];
            const u32x4 w = (u32x4){pk2(a[0], a[1]), pk2(a[2], a[3]), pk2(c[0], c[1]), pk2(c[2], c[3])};
            const bf16x8 pb = __builtin_bit_cast(bf16x8, w);
#pragma unroll
            for (int dt = 0; dt < 4; ++dt) {
                const int row = 16 * dt + l15;
                const bf16x8 av = *(const bf16x8*)(vd + row * 512 + (((4 * ks + quad) ^ (row & 15)) << 4));
                o[dt] = mfma16(av, pb, o[dt]);
            }
        }
#pragma unroll
        for (int dt = 0; dt < 4; ++dt) {
            const int d = 16 * dt + 4 * quad;
            const u32x2 gv = *(const u32x2*)(gx + (size_t)tok * 256 + 64 * h + d);
            const float o0 = o[dt][0] * inv * bf2f(gv[0] & 0xffffu), o1 = o[dt][1] * inv * bf2f(gv[0] >> 16);
            const float o2 = o[dt][2] * inv * bf2f(gv[1] & 0xffffu), o3 = o[dt][3] * inv * bf2f(gv[1] >> 16);
            *(u32x2*)(yo + y_off(chunk * 128 + tok, 768 + h * 64 + d)) = (u32x2){pk2(o0, o1), pk2(o2, o3)};
        }
    }
}

DI void unit_O(const Params& p, char* lds, int l, int tile) {
    const int tid = opaque_tid(), lane = tid & 63, wid = tid >> 6, l15 = lane & 15, quad = lane >> 4;
    glu_prologue(p, lds, l, tile);
    f32x4 acc[4][8];
    gemm_main<64, 1024, 1, 8, 1, true, 2>(WS_PTR(const bf16_t, OFF_Y) + (size_t)tile * 64 * 1024, WS_PTR(const bf16_t, OFF_WOUT) + (size_t)l * 1024 * 1024, 1024 * 32, lds, acc);
    const float* xres = (l == 0) ? p.x : WS_PTR(const float, OFF_X1);
    const size_t r0 = (size_t)tile * 64;
    char* XR = lds;
    float* GB = (float*)(lds + 131072);
    float* red = (float*)(lds + 139264);
    const int xrot = (int)(((blockIdx.x >> 3) + (blockIdx.x & 7) * 4) & 31) * 4;
    const bf16_t* xbres = WS_PTR(const bf16_t, OFF_XB1) + ((size_t)((tile >> 1) * 32) * 128 + (tile & 1) * 64) * 32;
    auto issue_x = [&](int half) {
        if (l == 0) {
#pragma unroll 1
            for (int i = 0; i < 16; ++i) {
                const int pc = (wid * 16 + i + xrot) & 127, row = pc >> 2, phys = (pc & 3) * 64 + lane, logical = phys ^ (row & 15);
                __builtin_amdgcn_global_load_lds((const unsigned*)(xres + (r0 + half * 32 + row) * 1024 + logical * 4), (unsigned*)(XR + pc * 1024 + lane * 16), 16, 0, 0);
            }
        } else {
#pragma unroll 1
            for (int i = 0; i < 8; ++i) {
                const int pc = (wid * 8 + i + (xrot >> 1)) & 63, kt = pc >> 1, sub = pc & 1;
                __builtin_amdgcn_global_load_lds((const unsigned*)(xbres + ((size_t)kt * 128 + half * 32) * 32 + sub * 512 + lane * 8), (unsigned*)(XR + pc * 1024 + lane * 16), 16, 0, 0);
            }
        }
    };
    issue_x(0);
    {
        const float* gsrc = (tid < 256) ? (p.ln_g + l * 1024 + tid * 4) : (p.ln_b + l * 1024 + (tid - 256) * 4);
        *(f32x4*)(GB + tid * 4) = *(const f32x4*)gsrc;
    }
    float* xo = (l == 0) ? WS_PTR(float, OFF_X1) : p.out;
    bf16_t* xbo = WS_PTR(bf16_t, OFF_XB1);
#pragma unroll
    for (int half = 0; half < 2; ++half) {
        if (half == 0) wait_vm<0>();
        else wait_vm<8>();
        __syncthreads();
        float s2[2], ss2[2];
#pragma unroll
        for (int mh = 0; mh < 2; ++mh) {
            const int mt = half * 2 + mh, rl = mh * 16 + l15;
            float s = 0.f, ss = 0.f;
#pragma unroll
            for (int nt = 0; nt < 8; ++nt) {
                f32x4 xr;
                if (l == 0) {
                    const int chunk = wid * 32 + nt * 4 + quad;
                    xr = *(const f32x4*)(XR + rl * 4096 + ((chunk ^ l15) << 4));
                } else {
                    const u32x2 hb = *(const u32x2*)(XR + ((wid * 4 + (nt >> 1)) * 32 + rl) * 64 + (nt & 1) * 32 + quad * 8);
                    xr = (f32x4){bf2f(hb[0] & 0xffffu), bf2f(hb[0] >> 16), bf2f(hb[1] & 0xffffu), bf2f(hb[1] >> 16)};
                }
#pragma unroll
                for (int i = 0; i < 4; ++i) { const float v = acc[mt][nt][i] + DN_ALPHA * xr[i]; acc[mt][nt][i] = v; s += v; ss += v * v; }
            }
            s2[mh] = s; ss2[mh] = ss;
        }
#pragma unroll
        for (int mh = 0; mh < 2; ++mh) { s2[mh] += __shfl_xor(s2[mh], 16); ss2[mh] += __shfl_xor(ss2[mh], 16); }
#pragma unroll
        for (int mh = 0; mh < 2; ++mh) { s2[mh] += __shfl_xor(s2[mh], 32); ss2[mh] += __shfl_xor(ss2[mh], 32); }
        if (quad == 0) {
#pragma unroll
            for (int mh = 0; mh < 2; ++mh) *(f32x2*)&red[((mh * 16 + l15) * 8 + wid) * 2] = (f32x2){s2[mh], ss2[mh]};
        }
        __syncthreads();
        if (half == 0) issue_x(1);
#pragma unroll
        for (int mh = 0; mh < 2; ++mh) {
            const int mt = half * 2 + mh, rl = mh * 16 + l15, row = mt * 16 + l15;
            float s = 0.f, ss = 0.f;
#pragma unroll
            for (int w = 0; w < 4; ++w) { const f32x4 v = *(const f32x4*)&red[rl * 16 + 4 * w]; s += v[0] + v[2]; ss += v[1] + v[3]; }
            const float mu = s * (1.f / 1024.f);
            const float var = ss * (1.f / 1024.f) - mu * mu;
            const float rs = rsqrtf(var + LN_EPS);
            float* orow = xo + (r0 + row) * 1024 + wid * 128 + quad * 4;
            bf16_t* brow = xbo + xb_off((int)r0 + row, wid * 128) + quad * 4;
            const float* gp = GB + wid * 128 + quad * 4;
#pragma unroll
            for (int nt = 0; nt < 8; ++nt) {
                const f32x4 g = *(const f32x4*)(gp + nt * 16), bb = *(const f32x4*)(gp + 1024 + nt * 16);
                f32x4 o;
#pragma unroll
                for (int i = 0; i < 4; ++i) o[i] = (acc[mt][nt][i] - mu) * rs * g[i] + bb[i];
                if (l == 0) *(u32x2*)(brow + (nt >> 1) * 4096 + (nt & 1) * 16) = (u32x2){pk2(o[0], o[1]), pk2(o[2], o[3])};
                else *(f32x4*)(orow + nt * 16) = o;
            }
        }
    }
}

DI void fast_grid_barrier(unsigned* ctr, unsigned target) {
    wait_vm<0>();
    __syncthreads();
    if (threadIdx.x == 0) {
        __builtin_amdgcn_fence(__ATOMIC_RELEASE, "agent");
        __hip_atomic_fetch_add(ctr, 1u, __ATOMIC_RELAXED, __HIP_MEMORY_SCOPE_AGENT);
        while (__hip_atomic_load(ctr, __ATOMIC_RELAXED, __HIP_MEMORY_SCOPE_AGENT) < target) __builtin_amdgcn_s_sleep(1);
        __builtin_amdgcn_fence(__ATOMIC_ACQUIRE, "agent");
    }
    __syncthreads();
}

__global__ void __launch_bounds__(NTHR) mega_fwd(Params p) {
    extern __shared__ __attribute__((aligned(16))) char lds[];
    cg::grid_group grid = cg::this_grid();
    const int nb = gridDim.x, bid = blockIdx.x;
    if (bid == 0 && threadIdx.x < 256) __hip_atomic_store(WS_PTR(unsigned, OFF_HL) + threadIdx.x, 0u, __ATOMIC_RELAXED, __HIP_MEMORY_SCOPE_AGENT);
    prep_phase(p, lds);
    unsigned* bar = WS_PTR(unsigned, OFF_HL);
    for (int ph = 0; ph < 4; ++ph) {
        if (ph == 0) grid.sync(); else fast_grid_barrier(bar, (unsigned)ph * (unsigned)nb);
        const int l = ph >> 1;
        if ((ph & 1) == 0) {
            const int nkv = (l == 0) ? 256 : 0, nunits = 256 + nkv + 1024 + 256 + 256;
            for (int u = bid; u < nunits; u += nb) {
                int v = u;
                if (v < 256) { unit_B1(p, lds, l, v); continue; }
                v -= 256;
                if (v < nkv) { unit_KV(p, lds, v >> 7, (v >> 2) & 31, v & 3); continue; }
                v -= nkv;
                if (v < 1024) { unit_A(p, lds, l, v & 255, v >> 8); continue; }
                v -= 1024;
                const int s = v & 255, xcd = s & 7, i = s >> 3;
                if (v < 256) unit_X(p, lds, l, xcd * 32 + i);
                else unit_S5(p, lds, l, xcd * 2 + (i >> 4), i & 15);
            }
        } else {
            for (int u = bid; u < 512; u += nb) unit_O(p, lds, l, u);
        }
    }
}

extern "C" void kernel_launch(void* const* d_in, const int* in_sizes, int n_in, void* d_out, int out_size, void* d_ws, size_t ws_size, hipStream_t stream) {
    static int grid_blocks = 0;
    if (!grid_blocks) {
        int dev = 0, cus = 0, per_cu = 0;
        hipGetDevice(&dev);
        hipDeviceGetAttribute(&cus, hipDeviceAttributeMultiprocessorCount, dev);
        hipFuncSetAttribute((const void*)mega_fwd, hipFuncAttributeMaxDynamicSharedMemorySize, LDS_BYTES);
        hipOccupancyMaxActiveBlocksPerMultiprocessor(&per_cu, mega_fwd, NTHR, LDS_BYTES);
        if (per_cu < 1) per_cu = 1;
        grid_blocks = cus * per_cu;
        if (grid_blocks > 256) grid_blocks = 256;
    }
    Params p{};
    const float** pp = (const float**)&p;
    for (int i = 0; i < 22; ++i) pp[i] = (const float*)d_in[i];
    p.out = (float*)d_out;
    p.ws = (char*)d_ws;
    void* args[] = {&p};
    hipError_t e = hipLaunchCooperativeKernel((void*)mega_fwd, dim3(grid_blocks), dim3(NTHR), args, LDS_BYTES, stream);
    if (e != hipSuccess) fprintf(stderr, "cooperative launch failed: %s (grid %d)\n", hipGetErrorString(e), grid_blocks);
}
```

```cpp
#include <hip/hip_runtime.h>
#include <hip/hip_cooperative_groups.h>
#include <cstdio>
#include <cstdint>
namespace cg = cooperative_groups;

typedef unsigned short bf16_t;
typedef short bf16x8 __attribute__((ext_vector_type(8)));
typedef float f32x4 __attribute__((ext_vector_type(4)));
typedef float f32x2 __attribute__((ext_vector_type(2)));
typedef unsigned u32x4 __attribute__((ext_vector_type(4)));
typedef unsigned u32x2 __attribute__((ext_vector_type(2)));
#define DI __device__ __forceinline__

constexpr int T_TOK = 32768, DM = 1024;
constexpr int NTHR = 512;
constexpr size_t OFF_XB0 = 0;
constexpr size_t OFF_XB1 = OFF_XB0 + (size_t)T_TOK * DM * 2;
constexpr size_t OFF_X1 = OFF_XB1 + (size_t)T_TOK * DM * 2;
constexpr size_t OFF_Y = OFF_X1 + (size_t)T_TOK * DM * 4;
constexpr size_t OFF_PRE = OFF_Y + (size_t)T_TOK * DM * 2;
constexpr size_t OFF_XBB = OFF_PRE;
constexpr size_t OFF_YS = OFF_PRE + (size_t)T_TOK * 256 * 2;
constexpr size_t OFF_SG = OFF_PRE + (size_t)T_TOK * 256 * 4;
constexpr size_t OFF_HL = OFF_SG + (size_t)T_TOK * 256 * 2;
constexpr size_t OFF_MEMB = OFF_HL + (size_t)256 * 1024 * 2 * 4;
constexpr size_t OFF_WIN = OFF_MEMB + (size_t)4096 * 1024 * 2;
constexpr size_t OFF_WOUT = OFF_WIN + (size_t)2 * 2560 * 1024 * 2;
constexpr size_t OFF_WGLU = OFF_WOUT + (size_t)2 * 1024 * 1024 * 2;
constexpr size_t OFF_WKV = OFF_WGLU + (size_t)2 * 256 * 256 * 2;
constexpr size_t OFF_WSP = OFF_WKV + (size_t)2 * 512 * 1024 * 2;
constexpr size_t OFF_S5T = OFF_WSP + (size_t)2 * 4 * 128 * 128 * 2;
constexpr size_t OFF_L8 = OFF_S5T + (size_t)32 * 3 * 128 * 128 * 2;
constexpr size_t OFF_L128 = OFF_L8 + (size_t)32 * 64 * 2 * 4;
constexpr size_t OFF_KB = OFF_L128 + (size_t)32 * 64 * 2 * 4;
constexpr size_t OFF_VP = OFF_KB + (size_t)2 * 4096 * 256 * 2;
constexpr size_t OFF_GX = OFF_VP + (size_t)2 * 4096 * 256 * 2;
constexpr size_t WS_TOTAL = OFF_GX + (size_t)T_TOK * 256 * 2;

constexpr int LDS_BYTES = 147456;
constexpr float LN_EPS = 1e-5f;
constexpr float DN_ALPHA = 1.41421356237f;

struct Params {
    const float *x, *mem, *w_in, *gm_w_s, *gm_b_s, *gm_ln_g, *gm_ln_b, *lam_re, *lam_im, *log_step, *b_re, *b_im, *c_re, *c_im, *ssm_d, *glu_w, *glu_b, *w_k,
        *w_v, *w_out, *ln_g, *ln_b;
    float* out;
    char* ws;
};

typedef __bf16 bf16x2_t __attribute__((ext_vector_type(2)));
DI unsigned pk2(float lo, float hi) { const f32x2 v = {lo, hi}; const bf16x2_t b = __builtin_convertvector(v, bf16x2_t); return __builtin_bit_cast(unsigned, b); }
DI unsigned bf16_bits(float x) { return pk2(x, 0.f) & 0xffffu; }
DI float bf2f(unsigned b) { return __uint_as_float(b << 16); }
DI float sigmoid_f(float x) { return __builtin_amdgcn_rcpf(1.f + __builtin_amdgcn_exp2f(x * -1.44269504089f)); }
DI float silu_f(float x) { return x * sigmoid_f(x); }
DI float gelu_f(float x) {
    const float t = x * (-2.30220819f + -0.102943240f * (x * x));
    return x * __builtin_amdgcn_rcpf(1.f + __builtin_amdgcn_exp2f(t));
}
DI int opaque_tid() { int t = threadIdx.x; asm volatile("" : "+v"(t)); return t; }
DI f32x4 mfma16(bf16x8 a, bf16x8 b, f32x4 c) { return __builtin_amdgcn_mfma_f32_16x16x32_bf16(a, b, c, 0, 0, 0); }

template <int N> DI void wait_vm() { asm volatile("s_waitcnt vmcnt(%0)" ::"n"(N) : "memory"); }
DI void raw_barrier() { asm volatile("" ::: "memory"); __builtin_amdgcn_s_barrier(); asm volatile("" ::: "memory"); }

template <int BM, int BN, int WR, int WC, int NSEG, bool SWAP, int NST, int DBG = 0>
DI void gemm_main(const bf16_t* __restrict__ A, const bf16_t* __restrict__ Bt, const int ldbk, char* lds, f32x4 (&acc)[BM / WR / 16][BN / WC / 16]) {
    constexpr int WM = BM / WR, WN = BN / WC, MT = WM / 16, NT = WN / 16, ROWS = BM + BN, NCH = ROWS * 4, NIT = (NCH + 511) / 512, BUF = ROWS * 64, KT = 32;
    constexpr int NTS = NT / NSEG, D = NST - 1;
    static_assert(D == 1 || (NCH % 512 == 0), "deep ring needs a uniform per-thread load count");
    const int tid = opaque_tid(), lane = tid & 63, wid = tid >> 6, wr = wid / WC, wc = wid % WC, l15 = lane & 15, quad = lane >> 4;
    const int lrow = tid >> 2, lc = tid & 3;
    const int lcg = lc ^ ((0 - (tid >> 4)) & 3);
    const int rsw = (quad ^ ((0 - (l15 >> 2)) & 3)) << 4;
#pragma unroll
    for (int mt = 0; mt < MT; ++mt)
#pragma unroll
        for (int nt = 0; nt < NT; ++nt) acc[mt][nt] = (f32x4){0.f, 0.f, 0.f, 0.f};
    const unsigned loff = (unsigned)(lrow * 64 + lcg * 16);
    const int koff = (int)((blockIdx.x >> 3) + (blockIdx.x & 7) * 4) & (KT - 1);
    auto issue_one = [&](int kt, int b, int i) {
        const int row = lrow + 128 * i;
        if ((NCH % 512 == 0) || (i < NCH / 512) || row < ROWS) {
            const int kq = (kt + koff) & (KT - 1);
            const char* ua = (const char*)A + (size_t)((DBG & 1) ? 0 : kq) * (BM * 64);
            const char* ub = (const char*)Bt + (size_t)((DBG & 2) ? 0 : kq) * ((size_t)ldbk * 2);
            const char* src;
            if (BM % 128 == 0) src = (i < BM / 128) ? (ua + i * 8192 + loff) : (ub + (i * 128 - BM) * 64 + loff);
            else if (i == 0) src = (lrow < BM) ? (ua + loff) : (ub + loff - BM * 64);
            else src = ub + (i * 128 - BM) * 64 + loff;
            __builtin_amdgcn_global_load_lds((const unsigned*)src, (unsigned*)(lds + b * BUF + i * 8192 + tid * 16), 16, 0, 0);
        }
    };
    auto issue = [&](int kt, int b) {
#pragma unroll
        for (int i = 0; i < NIT; ++i) issue_one(kt, b, i);
    };
    auto compute = [&](int cb, bool do_issue, int ikt, int ib) {
        const char* base = lds + cb * BUF;
        bf16x8 af[MT], bfr[NT];
#pragma unroll
        for (int nt = 0; nt < NT; ++nt) {
            const int br = BM + (nt / NTS) * (BN / NSEG) + wc * (NTS * 16) + (nt % NTS) * 16;
            bfr[nt] = *(const bf16x8*)(base + (br + l15) * 64 + rsw);
        }
#pragma unroll
        for (int mt = 0; mt < MT; ++mt) af[mt] = *(const bf16x8*)(base + (wr * WM + mt * 16 + l15) * 64 + rsw);
        constexpr int TOT = MT * NT, PER = (TOT + NIT - 1) / NIT;
#pragma unroll
        for (int part = 0; part < NIT; ++part) {
#pragma unroll
            for (int q = 0; q < PER; ++q) {
                const int idx = part * PER + q;
                if (idx < TOT) {
                    const int mt = idx / NT, nt = idx % NT;
                    acc[mt][nt] = SWAP ? mfma16(bfr[nt], af[mt], acc[mt][nt]) : mfma16(af[mt], bfr[nt], acc[mt][nt]);
                }
            }
            __builtin_amdgcn_sched_barrier(0);
            if (do_issue) issue_one(ikt, ib, part);
            __builtin_amdgcn_sched_barrier(0);
        }
    };
    __syncthreads();
#pragma unroll
    for (int d = 0; d < D; ++d) issue(d, d);
    int cb = 0, ib = D;
    for (int kt = 0; kt < KT; ++kt) {
        if (D > 1 && kt + D - 1 < KT) wait_vm<(D - 1) * NIT>(); else wait_vm<0>();
        raw_barrier();
        compute(cb, kt + D < KT, kt + D, ib);
        cb = (cb + 1 == NST) ? 0 : cb + 1;
        ib = (ib + 1 == NST) ? 0 : ib + 1;
    }
    __syncthreads();
}

DI size_t y_off(int tok, int col) { return ((size_t)(((tok >> 6) * 32 + (col >> 5)) * 64 + (tok & 63))) * 32 + (col & 31); }
DI size_t xb_off(int tok, int col) { return ((size_t)(((tok >> 7) * 32 + (col >> 5)) * 128 + (tok & 127))) * 32 + (col & 31); }
#define WS_PTR(T, off) ((T*)(p.ws + (off)))

DI void transpose_tile(const float* __restrict__ src, int ldsrc, bf16_t* __restrict__ dst, int ntot, int n0, int k0, float* tile) {
    const int tid = threadIdx.x, c = tid & 63, r0 = tid >> 6;
#pragma unroll
    for (int i = 0; i < 8; ++i) { const int r = r0 + 8 * i; tile[r * 65 + c] = src[(size_t)r * ldsrc + c]; }
    __syncthreads();
#pragma unroll
    for (int i = 0; i < 8; ++i) {
        const int rr = r0 + 8 * i, k = k0 + c;
        dst[((size_t)(k >> 5) * ntot + n0 + rr) * 32 + (k & 31)] = (bf16_t)bf16_bits(tile[c * 65 + rr]);
    }
    __syncthreads();
}

DI void transpose_glu(const float* __restrict__ src, bf16_t* __restrict__ dst, float* tile) {
    const int tid = threadIdx.x, c = tid & 63, r0 = tid >> 6;
#pragma unroll
    for (int i = 0; i < 8; ++i) { const int r = r0 + 8 * i; tile[r * 65 + c] = src[(size_t)r * 256 + c]; }
    __syncthreads();
#pragma unroll
    for (int i = 0; i < 8; ++i) { const int rr = r0 + 8 * i; dst[(size_t)rr * 256 + c] = (bf16_t)bf16_bits(tile[c * 65 + rr]); }
    __syncthreads();
}

DI void s5_tables(const Params& p, char* lds, int lg) {
    const int tid = threadIdx.x;
    float* Lr = (float*)lds;
    float* Li = Lr + 9 * 64;
    float* Wr = Li + 9 * 64;
    float* Wi = Wr + 64;
    float* Bbr = Wi + 64;
    float* Bbi = Bbr + 1024;
    float* Cr = Bbi + 1024;
    float* Ci = Cr + 1024;
    float* Kt = Ci + 1024;
    __syncthreads();
    if (tid < 64) {
        const int pp = tid;
        const float dt = __expf(p.log_step[lg]);
        const float lr = p.lam_re[lg * 64 + pp], li = p.lam_im[lg * 64 + pp];
        const float a = lr * dt, b = li * dt;
        const float ea = expf(a);
        float sb, cb;
        sincosf(b, &sb, &cb);
        const float Lre = ea * cb, Lim = ea * sb;
        const float sh = sinf(0.5f * b);
        const float m1r = expm1f(a) * cb - 2.f * sh * sh, m1i = ea * sb;
        const float inv = 1.f / (lr * lr + li * li);
        Wr[pp] = (m1r * lr + m1i * li) * inv;
        Wi[pp] = (m1i * lr - m1r * li) * inv;
        float pr = 1.f, pi = 0.f;
#pragma unroll
        for (int t = 0; t < 9; ++t) {
            Lr[t * 64 + pp] = pr; Li[t * 64 + pp] = pi;
            const float nr = pr * Lre - pi * Lim, ni = pr * Lim + pi * Lre;
            pr = nr; pi = ni;
        }
        float qr = Lr[8 * 64 + pp], qi = Li[8 * 64 + pp];
        f32x2* L8 = WS_PTR(f32x2, OFF_L8);
        L8[lg * 64 + pp] = (f32x2){qr, qi};
#pragma unroll
        for (int s = 0; s < 4; ++s) { const float nr = qr * qr - qi * qi, ni = 2.f * qr * qi; qr = nr; qi = ni; }
        f32x2* L128 = WS_PTR(f32x2, OFF_L128);
        L128[lg * 64 + pp] = (f32x2){qr, qi};
    }
    __syncthreads();
    for (int e = tid; e < 1024; e += NTHR) {
        const int pp = e >> 4;
        const float br = p.b_re[lg * 1024 + e], bi = p.b_im[lg * 1024 + e];
        Bbr[e] = Wr[pp] * br - Wi[pp] * bi;
        Bbi[e] = Wr[pp] * bi + Wi[pp] * br;
        Cr[e] = p.c_re[lg * 1024 + e];
        Ci[e] = p.c_im[lg * 1024 + e];
    }
    __syncthreads();
    for (int e = tid; e < 2048; e += NTHR) {
        const int tau = e >> 8, c = (e >> 4) & 15, c2 = e & 15;
        float s = 0.f;
        for (int pp = 0; pp < 64; ++pp) {
            const float cr = Cr[c * 64 + pp], ci = Ci[c * 64 + pp], lr = Lr[tau * 64 + pp], li = Li[tau * 64 + pp];
            const float tr = cr * lr - ci * li, ti = cr * li + ci * lr;
            s += tr * Bbr[pp * 16 + c2] - ti * Bbi[pp * 16 + c2];
        }
        Kt[e] = s;
    }
    __syncthreads();
    bf16_t* T = WS_PTR(bf16_t, OFF_S5T) + (size_t)lg * 3 * 16384;
    for (int e = tid; e < 16384; e += NTHR) {
        const int n = e >> 7, k = e & 127;
        {
            const int tlo = n >> 4, c = n & 15, tli = k >> 4, c2 = k & 15;
            const float v = (tli <= tlo) ? Kt[((tlo - tli) * 16 + c) * 16 + c2] : 0.f;
            T[e] = (bf16_t)bf16_bits(v);
        }
        {
            const int pp = n & 63, ri = n >> 6, tli = k >> 4, c2 = k & 15;
            const float lr = Lr[(7 - tli) * 64 + pp], li = Li[(7 - tli) * 64 + pp], br = Bbr[pp * 16 + c2], bi = Bbi[pp * 16 + c2];
            const float v = ri ? (lr * bi + li * br) : (lr * br - li * bi);
            T[16384 + e] = (bf16_t)bf16_bits(v);
        }
        {
            const int tlo = n >> 4, c = n & 15, pp = k & 63, ri = k >> 6;
            const float lr = Lr[(tlo + 1) * 64 + pp], li = Li[(tlo + 1) * 64 + pp], cr = Cr[c * 64 + pp], ci = Ci[c * 64 + pp];
            const float v = ri ? -(cr * li + ci * lr) : (cr * lr - ci * li);
            T[32768 + e] = (bf16_t)bf16_bits(v);
        }
    }
    __syncthreads();
}

DI void prep_phase(const Params& p, char* lds) {
    const int tid = opaque_tid(), nb = gridDim.x, bid = blockIdx.x;
    for (int j = bid; j < 32; j += nb) s5_tables(p, lds, j);
    {
        float* tile = (float*)lds;
        for (int T = bid; T < 2080; T += nb) {
            const int l = T / 1040; int r = T % 1040;
            if (r < 640) {
                const int nt = r >> 4, kt = r & 15, n0 = nt * 64;
                int sc = n0;
                if (n0 < 1536) { const int h = n0 / 384, rem = n0 % 384, seg = rem >> 7, d0 = rem & 127; sc = seg * 512 + h * 128 + d0; }
                transpose_tile(p.w_in + (size_t)l * 1024 * 2560 + (size_t)(kt * 64) * 2560 + sc, 2560, WS_PTR(bf16_t, OFF_WIN) + (size_t)l * 2560 * 1024, 2560, n0, kt * 64, tile);
            } else if (r < 896) {
                r -= 640; const int nt = r >> 4, kt = r & 15;
                transpose_tile(p.w_out + (size_t)l * 1024 * 1024 + (size_t)(kt * 64) * 1024 + nt * 64, 1024, WS_PTR(bf16_t, OFF_WOUT) + (size_t)l * 1024 * 1024, 1024, nt * 64, kt * 64, tile);
            } else if (r < 912) {
                r -= 896; const int nt = r >> 2, kt = r & 3;
                transpose_glu(p.glu_w + (size_t)l * 65536 + (size_t)(kt * 64) * 256 + nt * 64, WS_PTR(bf16_t, OFF_WGLU) + (size_t)l * 65536 + (size_t)(nt * 64) * 256 + kt * 64, tile);
            } else if (r < 976) {
                r -= 912; const int nt = r >> 4, kt = r & 15;
                transpose_tile(p.w_k + (size_t)l * 262144 + (size_t)(kt * 64) * 256 + nt * 64, 256, WS_PTR(bf16_t, OFF_WKV) + (size_t)l * 524288, 512, nt * 64, kt * 64, tile);
            } else {
                r -= 976; const int nt = r >> 4, kt = r & 15;
                transpose_tile(p.w_v + (size_t)l * 262144 + (size_t)(kt * 64) * 256 + nt * 64, 256, WS_PTR(bf16_t, OFF_WKV) + (size_t)l * 524288, 512, 256 + nt * 64, kt * 64, tile);
            }
        }
    }
    {
        bf16_t* W = WS_PTR(bf16_t, OFF_WSP);
        for (int e = bid * NTHR + tid; e < 2 * 4 * 128 * 128; e += nb * NTHR) {
            const int s = e & 127, t = (e >> 7) & 127;
            W[e] = (s <= t) ? (bf16_t)bf16_bits(p.gm_w_s[e]) : (bf16_t)0;
        }
    }
    {
        auto conv = [&](const float* __restrict__ srcp, bf16_t* __restrict__ dstp, size_t n8) {
            for (size_t I = (size_t)bid * NTHR + tid; I < n8; I += (size_t)nb * NTHR) {
                const int c8 = (int)(I & 3), row = (int)(I >> 2) & 127, kt = (int)(I >> 9) & 31, blk = (int)(I >> 14);
                const float* s = srcp + ((size_t)(blk * 128 + row)) * 1024 + kt * 32 + c8 * 8;
                const f32x4 a = *(const f32x4*)s, b = *(const f32x4*)(s + 4);
                *(u32x4*)(dstp + I * 8) = (u32x4){pk2(a[0], a[1]), pk2(a[2], a[3]), pk2(b[0], b[1]), pk2(b[2], b[3])};
            }
        };
        conv(p.x, WS_PTR(bf16_t, OFF_XB0), (size_t)T_TOK * DM / 8);
        conv(p.mem, WS_PTR(bf16_t, OFF_MEMB), (size_t)4096 * DM / 8);
    }
}

DI void signal_done(unsigned* c) {
    wait_vm<0>();
    __syncthreads();
    if (threadIdx.x == 0) { __builtin_amdgcn_fence(__ATOMIC_RELEASE, "agent"); __hip_atomic_fetch_add(c, 1u, __ATOMIC_RELAXED, __HIP_MEMORY_SCOPE_AGENT); }
}
DI void wait_count(unsigned* c, unsigned need) {
    if (threadIdx.x == 0) {
        while (__hip_atomic_load(c, __ATOMIC_RELAXED, __HIP_MEMORY_SCOPE_AGENT) < need) __builtin_amdgcn_s_sleep(1);
        __builtin_amdgcn_fence(__ATOMIC_ACQUIRE, "agent");
    }
    __syncthreads();
}

DI void unit_KV(const Params& p, char* lds, int l, int mtile, int q) {
    const int tid = opaque_tid(), lane = tid & 63, wid = tid >> 6, wr = wid >> 2, wc = wid & 3, l15 = lane & 15, quad = lane >> 4;
    f32x4 acc[4][2];
    gemm_main<128, 128, 2, 4, 1, true, 3>(WS_PTR(const bf16_t, OFF_MEMB) + (size_t)mtile * 128 * 1024, WS_PTR(const bf16_t, OFF_WKV) + (size_t)l * 524288 + (size_t)(128 * q) * 32, 512 * 32, lds, acc);
    bf16_t* Kb = WS_PTR(bf16_t, OFF_KB) + (size_t)l * 4096 * 256;
    bf16_t* Vp = WS_PTR(bf16_t, OFF_VP) + (size_t)l * 4096 * 256;
#pragma unroll
    for (int mt = 0; mt < 4; ++mt) {
        const int r = mtile * 128 + wr * 64 + mt * 16 + l15, b = r >> 8, m = r & 255;
#pragma unroll
        for (int nt = 0; nt < 2; ++nt) {
            const int col = 128 * q + wc * 32 + nt * 16 + quad * 4;
            const f32x4 v = acc[mt][nt];
            if (q < 2) {
                const int head = col >> 6, d = col & 63;
                *(u32x2*)(Kb + ((size_t)((b * 4 + head) * 256 + m)) * 64 + d) = (u32x2){pk2(v[0], v[1]), pk2(v[2], v[3])};
            } else {
                const int cv = col - 256, head = cv >> 6, d = cv & 63;
                const int rr = m & 31, pos = (m & ~31) + 8 * ((rr >> 2) & 3) + 4 * (rr >> 4) + (rr & 3);
#pragma unroll
                for (int i = 0; i < 4; ++i) Vp[((size_t)((b * 4 + head) * 64 + d + i)) * 256 + pos] = (bf16_t)bf16_bits(v[i]);
            }
        }
    }
    signal_done(WS_PTR(unsigned, OFF_HL) + 64 + l * 16 + (mtile >> 1));
}

template <int CTRL> DI float dpp_f(float v) { return __builtin_bit_cast(float, __builtin_amdgcn_update_dpp(0, __builtin_bit_cast(int, v), CTRL, 0xF, 0xF, true)); }
DI float row16_sum(float v) {
    v += dpp_f<0xB1>(v);
    v += dpp_f<0x4E>(v);
    v += dpp_f<0x141>(v);
    v += dpp_f<0x140>(v);
    return v;
}

DI void unit_A(const Params& p, char* lds, int l, int chunk, int h) {
    const int tid = opaque_tid(), lane = tid & 63, wid = tid >> 6, wr = wid >> 2, wc = wid & 3, l15 = lane & 15, quad = lane >> 4;
    f32x4 acc[4][6];
    const bf16_t* xb = WS_PTR(const bf16_t, l == 0 ? OFF_XB0 : OFF_XB1);
    char* WL = lds + 98304;
    __syncthreads();
    {
        const bf16_t* W = WS_PTR(const bf16_t, OFF_WSP) + (size_t)(l * 4 + h) * 16384;
#pragma unroll
        for (int i = 0; i < 4; ++i) {
            const int piece = wid + 8 * i, row = piece * 4 + (lane >> 4), lc = (lane & 15) ^ (row & 15);
            __builtin_amdgcn_global_load_lds((const unsigned*)(W + row * 128 + lc * 8), (unsigned*)(WL + piece * 1024 + lane * 16), 16, 0, 0);
        }
    }
    gemm_main<128, 384, 2, 4, 3, false, 3>(xb + (size_t)chunk * 128 * 1024, WS_PTR(const bf16_t, OFF_WIN) + (size_t)l * 2560 * 1024 + (size_t)h * 384 * 32, 2560 * 32, lds, acc);
    float* stat = (float*)lds;
    char* Vt = lds + 4096;
    float lgv[2], lbv[2];
#pragma unroll
    for (int n2 = 0; n2 < 2; ++n2) { const int d = wc * 32 + n2 * 16 + l15; lgv[n2] = p.gm_ln_g[(l * 4 + h) * 128 + d]; lbv[n2] = p.gm_ln_b[(l * 4 + h) * 128 + d]; }
    f32x4 bsv[4];
#pragma unroll
    for (int mt = 0; mt < 4; ++mt) bsv[mt] = *(const f32x4*)(p.gm_b_s + (l * 4 + h) * 128 + wr * 64 + mt * 16 + quad * 4);
    {
        float sv[4][4], ssv[4][4];
#pragma unroll
        for (int mt = 0; mt < 4; ++mt)
#pragma unroll
            for (int i = 0; i < 4; ++i) {
                float s = 0.f, ss = 0.f;
#pragma unroll
                for (int n2 = 0; n2 < 2; ++n2) { const float v = gelu_f(acc[mt][2 + n2][i]); acc[mt][2 + n2][i] = v; s += v; ss += v * v; }
                sv[mt][i] = s; ssv[mt][i] = ss;
            }
#pragma unroll
        for (int mt = 0; mt < 4; ++mt)
#pragma unroll
            for (int i = 0; i < 4; ++i) { sv[mt][i] = row16_sum(sv[mt][i]); ssv[mt][i] = row16_sum(ssv[mt][i]); }
        if (l15 == 0) {
#pragma unroll
            for (int mt = 0; mt < 4; ++mt)
#pragma unroll
                for (int i = 0; i < 4; ++i) { const int row = wr * 64 + mt * 16 + quad * 4 + i; *(f32x2*)&stat[(row * 4 + wc) * 2] = (f32x2){sv[mt][i], ssv[mt][i]}; }
        }
    }
    __syncthreads();
#pragma unroll
    for (int mt = 0; mt < 4; ++mt) {
        float mu[4], rs[4];
#pragma unroll
        for (int i = 0; i < 4; ++i) {
            const int row = wr * 64 + mt * 16 + quad * 4 + i;
            const f32x4 a = *(const f32x4*)&stat[row * 8], b = *(const f32x4*)&stat[row * 8 + 4];
            const float s = (a[0] + a[2]) + (b[0] + b[2]), ss = (a[1] + a[3]) + (b[1] + b[3]);
            mu[i] = s * (1.f / 128.f);
            const float var = ss * (1.f / 128.f) - mu[i] * mu[i];
            rs[i] = rsqrtf(var + LN_EPS);
        }
#pragma unroll
        for (int n2 = 0; n2 < 2; ++n2) {
            const int d = wc * 32 + n2 * 16 + l15;
            float v[4];
#pragma unroll
            for (int i = 0; i < 4; ++i) v[i] = (acc[mt][2 + n2][i] - mu[i]) * rs[i] * lgv[n2] + lbv[n2];
            *(u32x2*)(Vt + d * 272 + (wr * 64 + mt * 16 + quad * 4) * 2) = (u32x2){pk2(v[0], v[1]), pk2(v[2], v[3])};
        }
    }
    __syncthreads();
    f32x4 mx[4][2];
#pragma unroll
    for (int mt = 0; mt < 4; ++mt) { mx[mt][0] = (f32x4){0.f, 0.f, 0.f, 0.f}; mx[mt][1] = (f32x4){0.f, 0.f, 0.f, 0.f}; }
#pragma unroll
    for (int ks = 0; ks < 4; ++ks) {
        if (32 * ks <= 64 * wr + 63) {
            bf16x8 bv[2];
#pragma unroll
            for (int n2 = 0; n2 < 2; ++n2) bv[n2] = *(const bf16x8*)(Vt + (wc * 32 + n2 * 16 + l15) * 272 + (32 * ks + 8 * quad) * 2);
#pragma unroll
            for (int mt = 0; mt < 4; ++mt) {
                if (32 * ks <= 64 * wr + 16 * mt + 15) {
                    const bf16x8 aw = *(const bf16x8*)(WL + (wr * 64 + mt * 16 + l15) * 256 + (((4 * ks + quad) ^ l15) << 4));
                    mx[mt][0] = mfma16(aw, bv[0], mx[mt][0]);
                    mx[mt][1] = mfma16(aw, bv[1], mx[mt][1]);
                }
            }
        }
    }
    bf16_t* yo = WS_PTR(bf16_t, OFF_Y) + ((size_t)((chunk * 2 + wr) * 32 + 4 * h + wc) * 64 + quad * 4) * 32 + l15;
#pragma unroll
    for (int mt = 0; mt < 4; ++mt)
#pragma unroll
        for (int i = 0; i < 4; ++i) {
            const float b = bsv[mt][i];
#pragma unroll
            for (int n2 = 0; n2 < 2; ++n2) {
                const float val = gelu_f(acc[mt][n2][i]) * (mx[mt][n2][i] + b) * silu_f(acc[mt][4 + n2][i]);
                yo[(mt * 16 + i) * 32 + n2 * 16] = (bf16_t)bf16_bits(val);
            }
        }
}

#ifndef PROBE_DBG
#define PROBE_DBG -1
#endif
template <int DBG>
DI void unit_A_dummy(const Params& p, char* lds, int l, int chunk, int h) {
    f32x4 acc[4][6];
    const bf16_t* xb = WS_PTR(const bf16_t, l == 0 ? OFF_XB0 : OFF_XB1);
    gemm_main<128, 384, 2, 4, 3, false, 3, DBG>(xb + (size_t)chunk * 128 * 1024, WS_PTR(const bf16_t, OFF_WIN) + (size_t)l * 2560 * 1024 + (size_t)h * 384 * 32, 2560 * 32, lds, acc);
    float s = 0.f;
#pragma unroll
    for (int mt = 0; mt < 4; ++mt)
#pragma unroll
        for (int nt = 0; nt < 6; ++nt) s += acc[mt][nt][0] + acc[mt][nt][1] + acc[mt][nt][2] + acc[mt][nt][3];
    if (s == 123456.789f) WS_PTR(float, OFF_HL)[0] = s;
}

DI void unit_B1(const Params& p, char* lds, int l, int chunk) {
    const int tid = opaque_tid(), lane = tid & 63, wid = tid >> 6, wr = wid >> 2, wc = wid & 3, l15 = lane & 15, quad = lane >> 4;
    const bf16_t* xb = WS_PTR(const bf16_t, l == 0 ? OFF_XB0 : OFF_XB1);
    f32x4 acc[4][8];
    gemm_main<128, 512, 2, 4, 1, true, 3>(xb + (size_t)chunk * 128 * 1024, WS_PTR(const bf16_t, OFF_WIN) + (size_t)l * 2560 * 1024 + (size_t)1536 * 32, 2560 * 32, lds, acc);
    bf16_t* sgd = WS_PTR(bf16_t, OFF_SG) + (size_t)chunk * 128 * 256;
    bf16_t* xbd = WS_PTR(bf16_t, OFF_XBB) + (size_t)(chunk >> 4) * 16 * 2048 * 16;
#pragma unroll
    for (int mt = 0; mt < 4; ++mt) {
        const int tok = wr * 64 + mt * 16 + l15;
#pragma unroll
        for (int nt = 0; nt < 8; ++nt) {
            f32x4 v = acc[mt][nt];
            if (wc >= 2) {
                v[0] = silu_f(v[0]); v[1] = silu_f(v[1]); v[2] = silu_f(v[2]); v[3] = silu_f(v[3]);
                const int col = (wc & 1) * 128 + nt * 16 + quad * 4;
                *(u32x2*)(sgd + (size_t)tok * 256 + col) = (u32x2){pk2(v[0], v[1]), pk2(v[2], v[3])};
            } else {
                const int g = (wc & 1) * 8 + nt, tb = (chunk & 15) * 128 + tok;
                *(u32x2*)(xbd + ((size_t)g * 2048 + tb) * 16 + quad * 4) = (u32x2){pk2(v[0], v[1]), pk2(v[2], v[3])};
            }
        }
    }
    signal_done(WS_PTR(unsigned, OFF_HL) + 128 + l * 16 + (chunk >> 4));
}

DI void unit_S5(const Params& p, char* lds, int l, int b, int g) {
    const int tid = opaque_tid(), lane = tid & 63, wid = tid >> 6, l15 = lane & 15, quad = lane >> 4;
    const int lg = l * 16 + g;
    const bf16_t* T = WS_PTR(const bf16_t, OFF_S5T) + (size_t)lg * 3 * 16384;
    float* HLb = (float*)lds;
    float* EndS = (float*)(lds + 67584);
    bf16x8 wst[4], wintra[4], wcar[4];
#pragma unroll
    for (int ks = 0; ks < 4; ++ks) {
        wintra[ks] = *(const bf16x8*)(T + (16 * wid + l15) * 128 + 32 * ks + 8 * quad);
        wst[ks] = *(const bf16x8*)(T + 16384 + (16 * wid + l15) * 128 + 32 * ks + 8 * quad);
        wcar[ks] = *(const bf16x8*)(T + 32768 + (16 * wid + l15) * 128 + 32 * ks + 8 * quad);
    }
    const f32x2 L8 = WS_PTR(const f32x2, OFF_L8)[lg * 64 + lane], L128 = WS_PTR(const f32x2, OFF_L128)[lg * 64 + lane];
    const bf16_t* Xg = WS_PTR(const bf16_t, OFF_XBB) + ((size_t)(b * 16 + g) * 2048) * 16;
    bf16_t* YSo = WS_PTR(bf16_t, OFF_YS) + (size_t)b * 2048 * 256 + 16 * g;
    const float dsk = p.ssm_d[l * 256 + 16 * g + l15];
    char* Xl = lds + 75776;
    __syncthreads();
    wait_count(WS_PTR(unsigned, OFF_HL) + 128 + l * 16 + b, 16u);
#pragma unroll
    for (int i = 0; i < 8; ++i) {
        const int P = (wid * 8 + i) * 64 + lane, S = P ^ ((P >> 4) & 15);
        __builtin_amdgcn_global_load_lds((const unsigned*)(Xg + (size_t)S * 8), (unsigned*)(Xl + P * 16), 16, 0, 0);
    }
    wait_vm<0>();
    __syncthreads();
    auto xfrag = [&](int c, int ks) -> bf16x8 {
        const int tok = 128 * c + 8 * l15 + 2 * ks + (quad >> 1), S = tok * 2 + (quad & 1);
        return *(const bf16x8*)(Xl + ((S ^ ((S >> 4) & 15)) << 4));
    };
    for (int half = 0; half < 2; ++half) {
#pragma unroll 2
        for (int cl = 0; cl < 8; ++cl) {
            const int c = half * 8 + cl;
            f32x4 hl = (f32x4){0.f, 0.f, 0.f, 0.f};
#pragma unroll
            for (int ks = 0; ks < 4; ++ks) {
                const bf16x8 xa = xfrag(c, ks);
                hl = mfma16(xa, wst[ks], hl);
            }
#pragma unroll
            for (int i = 0; i < 4; ++i) HLb[cl * 2112 + (4 * quad + i) * 132 + 16 * wid + l15] = hl[i];
        }
        __syncthreads();
        {
            float* H = HLb + wid * 2112;
            float ar[16], ai[16];
#pragma unroll
            for (int j = 0; j < 16; ++j) { ar[j] = H[j * 132 + lane]; ai[j] = H[j * 132 + 64 + lane]; }
            float hr = 0.f, hi = 0.f;
#pragma unroll
            for (int j = 0; j < 16; ++j) {
                const float pr = hr, pi = hi;
                const float nr = L8.x * hr - L8.y * hi + ar[j], ni = L8.x * hi + L8.y * hr + ai[j];
                hr = nr; hi = ni;
                H[j * 132 + lane] = pr; H[j * 132 + 64 + lane] = pi;
            }
            EndS[(half * 8 + wid) * 128 + lane] = hr;
            EndS[(half * 8 + wid) * 128 + 64 + lane] = hi;
        }
        __syncthreads();
        {
            const int c = half * 8 + wid;
            float er[15], ei[15];
#pragma unroll
            for (int cc = 0; cc < 15; ++cc) { er[cc] = (cc < c) ? EndS[cc * 128 + lane] : 0.f; ei[cc] = (cc < c) ? EndS[cc * 128 + 64 + lane] : 0.f; }
            float* H = HLb + wid * 2112;
            float fr[16], fi[16];
#pragma unroll
            for (int j = 0; j < 16; ++j) { fr[j] = H[j * 132 + lane]; fi[j] = H[j * 132 + 64 + lane]; }
            float hr = 0.f, hi = 0.f;
#pragma unroll
            for (int cc = 0; cc < 15; ++cc) {
                if (cc < c) { const float nr = L128.x * hr - L128.y * hi + er[cc], ni = L128.x * hi + L128.y * hr + ei[cc]; hr = nr; hi = ni; }
            }
            asm volatile("s_waitcnt lgkmcnt(0)" ::: "memory");
#pragma unroll
            for (int j = 0; j < 16; ++j) {
                bf16_t* hp = (bf16_t*)(H + j * 132);
                hp[lane] = (bf16_t)bf16_bits(fr[j] + hr);
                hp[64 + lane] = (bf16_t)bf16_bits(fi[j] + hi);
                const float nr = L8.x * hr - L8.y * hi, ni = L8.x * hi + L8.y * hr;
                hr = nr; hi = ni;
            }
        }
        __syncthreads();
#pragma unroll 2
        for (int cl = 0; cl < 8; ++cl) {
            const int c = half * 8 + cl;
            const char* H = (const char*)(HLb + cl * 2112);
            f32x4 y = (f32x4){0.f, 0.f, 0.f, 0.f};
#pragma unroll
            for (int ks = 0; ks < 4; ++ks) {
                const bf16x8 xa = xfrag(c, ks);
                y = mfma16(xa, wintra[ks], y);
            }
#pragma unroll
            for (int ks = 0; ks < 4; ++ks) {
                const bf16x8 hp = *(const bf16x8*)(H + l15 * 528 + (32 * ks + 8 * quad) * 2);
                y = mfma16(hp, wcar[ks], y);
            }
#pragma unroll
            for (int i = 0; i < 4; ++i) {
                const int tokl = 128 * c + 8 * (4 * quad + i) + wid;
                const int S = tokl * 2 + (l15 >> 3);
                const float xv = bf2f(*(const bf16_t*)(Xl + ((S ^ ((S >> 4) & 15)) << 4) + (l15 & 7) * 2));
                YSo[(size_t)tokl * 256 + l15] = (bf16_t)bf16_bits(gelu_f(y[i] + dsk * xv));
            }
        }
        __syncthreads();
    }
}

template <int NT2>
DI void glu_prologue(const Params& p, char* lds, int l, int tile0, int tile1) {
    const int tid = opaque_tid(), lane = tid & 63, wid = tid >> 6, l15 = lane & 15, quad = lane >> 4;
    __syncthreads();
#pragma unroll
    for (int tt = 0; tt < NT2; ++tt) {
        const int tile = tt ? tile1 : tile0;
        char* Ys = lds + tt * 33792;
        const bf16_t* ysg = WS_PTR(const bf16_t, OFF_YS) + (size_t)tile * 64 * 256;
#pragma unroll
        for (int i = 0; i < 4; ++i) {
            const int idx = tid + NTHR * i, row = idx >> 5, c16 = idx & 31;
            *(u32x4*)(Ys + row * 528 + c16 * 16) = *(const u32x4*)(ysg + (size_t)row * 256 + c16 * 8);
        }
    }
    __syncthreads();
    f32x4 acc[NT2][4][2];
#pragma unroll
    for (int tt = 0; tt < NT2; ++tt)
#pragma unroll
        for (int mt = 0; mt < 4; ++mt) { acc[tt][mt][0] = (f32x4){0.f, 0.f, 0.f, 0.f}; acc[tt][mt][1] = (f32x4){0.f, 0.f, 0.f, 0.f}; }
    const bf16_t* Wg = WS_PTR(const bf16_t, OFF_WGLU) + (size_t)l * 65536;
#pragma unroll 2
    for (int ks = 0; ks < 8; ++ks) {
        bf16x8 bb[2];
#pragma unroll
        for (int nt = 0; nt < 2; ++nt) bb[nt] = *(const bf16x8*)(Wg + (wid * 32 + nt * 16 + l15) * 256 + 32 * ks + 8 * quad);
#pragma unroll
        for (int tt = 0; tt < NT2; ++tt) {
            const char* Ys = lds + tt * 33792;
            bf16x8 a[4];
#pragma unroll
            for (int mt = 0; mt < 4; ++mt) a[mt] = *(const bf16x8*)(Ys + (mt * 16 + l15) * 528 + (32 * ks + 8 * quad) * 2);
#pragma unroll
            for (int mt = 0; mt < 4; ++mt)
#pragma unroll
                for (int nt = 0; nt < 2; ++nt) acc[tt][mt][nt] = mfma16(bb[nt], a[mt], acc[tt][mt][nt]);
        }
    }
    bf16_t* yo = WS_PTR(bf16_t, OFF_Y);
#pragma unroll
    for (int tt = 0; tt < NT2; ++tt) {
        const int tile = tt ? tile1 : tile0;
        const char* Ys = lds + tt * 33792;
        const bf16_t* sg = WS_PTR(const bf16_t, OFF_SG) + (size_t)tile * 64 * 256;
#pragma unroll
        for (int mt = 0; mt < 4; ++mt) {
            const int tok = mt * 16 + l15;
#pragma unroll
            for (int nt = 0; nt < 2; ++nt) {
                const int n0 = wid * 32 + nt * 16 + quad * 4;
                const f32x4 gb = *(const f32x4*)(p.glu_b + l * 256 + n0);
                const u32x2 yv = *(const u32x2*)(Ys + tok * 528 + n0 * 2);
                const u32x2 sv = *(const u32x2*)(sg + (size_t)tok * 256 + n0);
                float o[4];
                o[0] = sigmoid_f(acc[tt][mt][nt][0] + gb[0]) * bf2f(yv[0] & 0xffffu) * bf2f(sv[0] & 0xffffu);
                o[1] = sigmoid_f(acc[tt][mt][nt][1] + gb[1]) * bf2f(yv[0] >> 16) * bf2f(sv[0] >> 16);
                o[2] = sigmoid_f(acc[tt][mt][nt][2] + gb[2]) * bf2f(yv[1] & 0xffffu) * bf2f(sv[1] & 0xffffu);
                o[3] = sigmoid_f(acc[tt][mt][nt][3] + gb[3]) * bf2f(yv[1] >> 16) * bf2f(sv[1] >> 16);
                *(u32x2*)(yo + y_off(tile * 64 + tok, 512 + n0)) = (u32x2){pk2(o[0], o[1]), pk2(o[2], o[3])};
            }
        }
    }
    wait_vm<0>();
}

DI void unit_X(const Params& p, char* lds, int l, int chunk) {
    const int tid = opaque_tid(), lane = tid & 63, wid = tid >> 6, wr = wid >> 2, wc = wid & 3, l15 = lane & 15, quad = lane >> 4;
    const bf16_t* xb = WS_PTR(const bf16_t, l == 0 ? OFF_XB0 : OFF_XB1);
    char* Qs = lds;
    bf16_t* gx = WS_PTR(bf16_t, OFF_GX) + (size_t)chunk * 128 * 256;
    {
        f32x4 acc[4][8];
        gemm_main<128, 512, 2, 4, 1, true, 3>(xb + (size_t)chunk * 128 * 1024, WS_PTR(const bf16_t, OFF_WIN) + (size_t)l * 2560 * 1024 + (size_t)2048 * 32, 2560 * 32, lds, acc);
#pragma unroll
        for (int mt = 0; mt < 4; ++mt) {
            const int tok = wr * 64 + mt * 16 + l15;
#pragma unroll
            for (int nt = 0; nt < 8; ++nt) {
                const f32x4 v = acc[mt][nt];
                if (wc < 2) {
                    const int col = wc * 128 + nt * 16 + quad * 4;
                    const float qs = 0.125f * 1.44269504089f;
                    *(u32x2*)(Qs + tok * 528 + col * 2) = (u32x2){pk2(v[0] * qs, v[1] * qs), pk2(v[2] * qs, v[3] * qs)};
                } else {
                    const int col = (wc - 2) * 128 + nt * 16 + quad * 4;
                    *(u32x2*)(gx + (size_t)tok * 256 + col) = (u32x2){pk2(silu_f(v[0]), silu_f(v[1])), pk2(silu_f(v[2]), silu_f(v[3]))};
                }
            }
        }
    }
    __syncthreads();
    bf16x8 bq[4][2];
#pragma unroll
    for (int h = 0; h < 4; ++h)
#pragma unroll
        for (int ks = 0; ks < 2; ++ks) bq[h][ks] = *(const bf16x8*)(Qs + (wid * 16 + l15) * 528 + (64 * h + 32 * ks + 8 * quad) * 2);
    const int b = chunk >> 4;
    if (l == 0) wait_count(WS_PTR(unsigned, OFF_HL) + 64 + l * 16 + b, 8u); else __syncthreads();
    const bf16_t* Kb = WS_PTR(const bf16_t, OFF_KB) + (size_t)l * 4096 * 256 + (size_t)(b * 4) * 256 * 64;
    const bf16_t* Vb = WS_PTR(const bf16_t, OFF_VP) + (size_t)l * 4096 * 256 + (size_t)(b * 4) * 64 * 256;
    bf16_t* yo = WS_PTR(bf16_t, OFF_Y);
    auto issue_kv = [&](int h, int buf) {
        const bf16_t* Kh = Kb + (size_t)h * 256 * 64;
        const bf16_t* Vh = Vb + (size_t)h * 64 * 256;
        char* kd = lds + buf * 65536;
        char* vd = kd + 32768;
#pragma unroll
        for (int i = 0; i < 4; ++i) {
            const int piece = wid + 8 * i;
            {
                const int row = piece * 8 + (lane >> 3), lc = (lane & 7) ^ ((row >> 1) & 7);
                __builtin_amdgcn_global_load_lds((const unsigned*)(Kh + row * 64 + lc * 8), (unsigned*)(kd + piece * 1024 + lane * 16), 16, 0, 0);
            }
            {
                const int row = piece * 2 + (lane >> 5), lc = (lane & 31) ^ (row & 15);
                __builtin_amdgcn_global_load_lds((const unsigned*)(Vh + row * 256 + lc * 8), (unsigned*)(vd + piece * 1024 + lane * 16), 16, 0, 0);
            }
        }
    };
    issue_kv(0, 0);
    const int tok = wid * 16 + l15;
#pragma unroll
    for (int h = 0; h < 4; ++h) {
        wait_vm<0>();
        raw_barrier();
        if (h < 3) issue_kv(h + 1, (h + 1) & 1);
        const char* kd = lds + (h & 1) * 65536;
        const char* vd = kd + 32768;
        f32x4 s[16];
#pragma unroll
        for (int mt = 0; mt < 16; ++mt) s[mt] = (f32x4){0.f, 0.f, 0.f, 0.f};
#pragma unroll
        for (int ks = 0; ks < 2; ++ks) {
#pragma unroll
            for (int mt = 0; mt < 16; ++mt) {
                const int row = 16 * mt + l15;
                const bf16x8 ak = *(const bf16x8*)(kd + row * 128 + (((4 * ks + quad) ^ ((row >> 1) & 7)) << 4));
                s[mt] = mfma16(ak, bq[h][ks], s[mt]);
            }
        }
        float mxv = -3.0e38f;
#pragma unroll
        for (int mt = 0; mt < 16; ++mt)
#pragma unroll
            for (int i = 0; i < 4; ++i) mxv = fmaxf(mxv, s[mt][i]);
        mxv = fmaxf(mxv, __shfl_xor(mxv, 16));
        mxv = fmaxf(mxv, __shfl_xor(mxv, 32));
        float sum = 0.f;
#pragma unroll
        for (int mt = 0; mt < 16; ++mt)
#pragma unroll
            for (int i = 0; i < 4; ++i) { const float e = __builtin_amdgcn_exp2f(s[mt][i] - mxv); s[mt][i] = e; sum += e; }
        sum += __shfl_xor(sum, 16);
        sum += __shfl_xor(sum, 32);
        const float inv = 1.f / sum;
        f32x4 o[4];
#pragma unroll
        for (int dt = 0; dt < 4; ++dt) o[dt] = (f32x4){0.f, 0.f, 0.f, 0.f};
#pragma unroll
        for (int ks = 0; ks < 8; ++ks) {
            const f32x4 a = s[2 * ks], c = s[2 * ks + 1];
            const u32x4 w = (u32x4){pk2(a[0], a[1]), pk2(a[2], a[3]), pk2(c[0], c[1]), pk2(c[2], c[3])};
            const bf16x8 pb = __builtin_bit_cast(bf16x8, w);
#pragma unroll
            for (int dt = 0; dt < 4; ++dt) {
                const int row = 16 * dt + l15;
                const bf16x8 av = *(const bf16x8*)(vd + row * 512 + (((4 * ks + quad) ^ (row & 15)) << 4));
                o[dt] = mfma16(av, pb, o[dt]);
            }
        }
#pragma unroll
        for (int dt = 0; dt < 4; ++dt) {
            const int d = 16 * dt + 4 * quad;
            const u32x2 gv = *(const u32x2*)(gx + (size_t)tok * 256 + 64 * h + d);
            const float o0 = o[dt][0] * inv * bf2f(gv[0] & 0xffffu), o1 = o[dt][1] * inv * bf2f(gv[0] >> 16);
            const float o2 = o[dt][2] * inv * bf2f(gv[1] & 0xffffu), o3 = o[dt][3] * inv * bf2f(gv[1] >> 16);
            *(u32x2*)(yo + y_off(chunk * 128 + tok, 768 + h * 64 + d)) = (u32x2){pk2(o0, o1), pk2(o2, o3)};
        }
    }
}

DI void unit_O(const Params& p, char* lds, int l, int tile, int glu_tiles, int tile_b) {
    const int tid = opaque_tid(), lane = tid & 63, wid = tid >> 6, l15 = lane & 15, quad = lane >> 4;
    if (glu_tiles == 2) glu_prologue<2>(p, lds, l, tile, tile_b); else if (glu_tiles == 1) glu_prologue<1>(p, lds, l, tile, tile);
    f32x4 acc[4][8];
    gemm_main<64, 1024, 1, 8, 1, true, 2>(WS_PTR(const bf16_t, OFF_Y) + (size_t)tile * 64 * 1024, WS_PTR(const bf16_t, OFF_WOUT) + (size_t)l * 1024 * 1024, 1024 * 32, lds, acc);
    const float* xres = (l == 0) ? p.x : WS_PTR(const float, OFF_X1);
    const size_t r0 = (size_t)tile * 64;
    char* XR = lds;
    float* GB = (float*)(lds + 131072);
    float* red = (float*)(lds + 139264);
    const int xrot = (int)(((blockIdx.x >> 3) + (blockIdx.x & 7) * 4) & 31) * 4;
    const bf16_t* xbres = WS_PTR(const bf16_t, OFF_XB1) + ((size_t)((tile >> 1) * 32) * 128 + (tile & 1) * 64) * 32;
    auto issue_x = [&](int half) {
        if (l == 0) {
#pragma unroll 1
            for (int i = 0; i < 16; ++i) {
                const int pc = (wid * 16 + i + xrot) & 127, row = pc >> 2, phys = (pc & 3) * 64 + lane, logical = phys ^ (row & 15);
                __builtin_amdgcn_global_load_lds((const unsigned*)(xres + (r0 + half * 32 + row) * 1024 + logical * 4), (unsigned*)(XR + pc * 1024 + lane * 16), 16, 0, 0);
            }
        } else {
#pragma unroll 1
            for (int i = 0; i < 8; ++i) {
                const int pc = (wid * 8 + i + (xrot >> 1)) & 63, kt = pc >> 1, sub = pc & 1;
                __builtin_amdgcn_global_load_lds((const unsigned*)(xbres + ((size_t)kt * 128 + half * 32) * 32 + sub * 512 + lane * 8), (unsigned*)(XR + pc * 1024 + lane * 16), 16, 0, 0);
            }
        }
    };
    issue_x(0);
    {
        const float* gsrc = (tid < 256) ? (p.ln_g + l * 1024 + tid * 4) : (p.ln_b + l * 1024 + (tid - 256) * 4);
        *(f32x4*)(GB + tid * 4) = *(const f32x4*)gsrc;
    }
    float* xo = (l == 0) ? WS_PTR(float, OFF_X1) : p.out;
    bf16_t* xbo = WS_PTR(bf16_t, OFF_XB1);
#pragma unroll
    for (int half = 0; half < 2; ++half) {
        if (half == 0) wait_vm<0>();
        else wait_vm<8>();
        __syncthreads();
        float s2[2], ss2[2];
#pragma unroll
        for (int mh = 0; mh < 2; ++mh) {
            const int mt = half * 2 + mh, rl = mh * 16 + l15;
            float s = 0.f, ss = 0.f;
#pragma unroll
            for (int nt = 0; nt < 8; ++nt) {
                f32x4 xr;
                if (l == 0) {
                    const int chunk = wid * 32 + nt * 4 + quad;
                    xr = *(const f32x4*)(XR + rl * 4096 + ((chunk ^ l15) << 4));
                } else {
                    const u32x2 hb = *(const u32x2*)(XR + ((wid * 4 + (nt >> 1)) * 32 + rl) * 64 + (nt & 1) * 32 + quad * 8);
                    xr = (f32x4){bf2f(hb[0] & 0xffffu), bf2f(hb[0] >> 16), bf2f(hb[1] & 0xffffu), bf2f(hb[1] >> 16)};
                }
#pragma unroll
                for (int i = 0; i < 4; ++i) { const float v = acc[mt][nt][i] + DN_ALPHA * xr[i]; acc[mt][nt][i] = v; s += v; ss += v * v; }
            }
            s2[mh] = s; ss2[mh] = ss;
        }
#pragma unroll
        for (int mh = 0; mh < 2; ++mh) { s2[mh] += __shfl_xor(s2[mh], 16); ss2[mh] += __shfl_xor(ss2[mh], 16); }
#pragma unroll
        for (int mh = 0; mh < 2; ++mh) { s2[mh] += __shfl_xor(s2[mh], 32); ss2[mh] += __shfl_xor(ss2[mh], 32); }
        if (quad == 0) {
#pragma unroll
            for (int mh = 0; mh < 2; ++mh) *(f32x2*)&red[((mh * 16 + l15) * 8 + wid) * 2] = (f32x2){s2[mh], ss2[mh]};
        }
        __syncthreads();
        if (half == 0) issue_x(1);
#pragma unroll
        for (int mh = 0; mh < 2; ++mh) {
            const int mt = half * 2 + mh, rl = mh * 16 + l15, row = mt * 16 + l15;
            float s = 0.f, ss = 0.f;
#pragma unroll
            for (int w = 0; w < 4; ++w) { const f32x4 v = *(const f32x4*)&red[rl * 16 + 4 * w]; s += v[0] + v[2]; ss += v[1] + v[3]; }
            const float mu = s * (1.f / 1024.f);
            const float var = ss * (1.f / 1024.f) - mu * mu;
            const float rs = rsqrtf(var + LN_EPS);
            float* orow = xo + (r0 + row) * 1024 + wid * 128 + quad * 4;
            bf16_t* brow = xbo + xb_off((int)r0 + row, wid * 128) + quad * 4;
            const float* gp = GB + wid * 128 + quad * 4;
#pragma unroll
            for (int nt = 0; nt < 8; ++nt) {
                const f32x4 g = *(const f32x4*)(gp + nt * 16), bb = *(const f32x4*)(gp + 1024 + nt * 16);
                f32x4 o;
#pragma unroll
                for (int i = 0; i < 4; ++i) o[i] = (acc[mt][nt][i] - mu) * rs * g[i] + bb[i];
                if (l == 0) *(u32x2*)(brow + (nt >> 1) * 4096 + (nt & 1) * 16) = (u32x2){pk2(o[0], o[1]), pk2(o[2], o[3])};
                else *(f32x4*)(orow + nt * 16) = o;
            }
        }
    }
}

DI void fast_grid_barrier(unsigned* ctr, unsigned target) {
    wait_vm<0>();
    __syncthreads();
    if (threadIdx.x == 0) {
        __builtin_amdgcn_fence(__ATOMIC_RELEASE, "agent");
        __hip_atomic_fetch_add(ctr, 1u, __ATOMIC_RELAXED, __HIP_MEMORY_SCOPE_AGENT);
        while (__hip_atomic_load(ctr, __ATOMIC_RELAXED, __HIP_MEMORY_SCOPE_AGENT) < target) __builtin_amdgcn_s_sleep(1);
        __builtin_amdgcn_fence(__ATOMIC_ACQUIRE, "agent");
    }
    __syncthreads();
}

__global__ void __launch_bounds__(NTHR) mega_fwd(Params p) {
    extern __shared__ __attribute__((aligned(16))) char lds[];
    cg::grid_group grid = cg::this_grid();
    const int nb = gridDim.x, bid = blockIdx.x;
    if (bid == 0 && threadIdx.x < 256) __hip_atomic_store(WS_PTR(unsigned, OFF_HL) + threadIdx.x, 0u, __ATOMIC_RELAXED, __HIP_MEMORY_SCOPE_AGENT);
    prep_phase(p, lds);
    unsigned* bar = WS_PTR(unsigned, OFF_HL);
    for (int ph = 0; ph < 4; ++ph) {
        if (ph == 0) grid.sync(); else fast_grid_barrier(bar, (unsigned)ph * (unsigned)nb);
        const int l = ph >> 1;
        if ((ph & 1) == 0) {
            const int nkv = (l == 0) ? 256 : 0, nunits = 256 + nkv + 1024 + 256 + 256;
            for (int u = bid; u < nunits; u += nb) {
                int v = u;
                if (v < 256) { unit_B1(p, lds, l, v); continue; }
                v -= 256;
                if (v < nkv) { unit_KV(p, lds, v >> 7, (v >> 2) & 31, v & 3); continue; }
                v -= nkv;
                if (v < 1024) { unit_A(p, lds, l, v & 255, v >> 8); continue; }
                v -= 1024;
                const int s = v & 255, xcd = s & 7, i = s >> 3;
                if (v < 256) unit_X(p, lds, l, xcd * 32 + i);
                else unit_S5(p, lds, l, xcd * 2 + (i >> 4), i & 15);
            }
        } else {
            for (int u = bid; u < 512; u += 2 * nb) {
                const int ub = u + nb;
                unit_O(p, lds, l, u, ub < 512 ? 2 : 1, ub);
                if (ub < 512) unit_O(p, lds, l, ub, 0, 0);
            }
        }
    }
}

extern "C" void kernel_launch(void* const* d_in, const int* in_sizes, int n_in, void* d_out, int out_size, void* d_ws, size_t ws_size, hipStream_t stream) {
    static int grid_blocks = 0;
    if (!grid_blocks) {
        int dev = 0, cus = 0, per_cu = 0;
        hipGetDevice(&dev);
        hipDeviceGetAttribute(&cus, hipDeviceAttributeMultiprocessorCount, dev);
        hipFuncSetAttribute((const void*)mega_fwd, hipFuncAttributeMaxDynamicSharedMemorySize, LDS_BYTES);
        hipOccupancyMaxActiveBlocksPerMultiprocessor(&per_cu, mega_fwd, NTHR, LDS_BYTES);
        if (per_cu < 1) per_cu = 1;
        grid_blocks = cus * per_cu;
        if (grid_blocks > 256) grid_blocks = 256;
    }
    Params p{};
    const float** pp = (const float**)&p;
    for (int i = 0; i < 22; ++i) pp[i] = (const float*)d_in[i];
    p.out = (float*)d_out;
    p.ws = (char*)d_ws;
    void* args[] = {&p};
    hipError_t e = hipLaunchCooperativeKernel((void*)mega_fwd, dim3(grid_blocks), dim3(NTHR), args, LDS_BYTES, stream);
    if (e != hipSuccess) fprintf(stderr, "cooperative launch failed: %s (grid %d)\n", hipGetErrorString(e), grid_blocks);
}
```
